# Optimizing an MI355X kernel written in HIP

```python
import math
import jax, jax.numpy as jnp
from jax import lax
import numpy as np

D_MODEL = 1024
BATCH = 2
SEQ = 8192
DEPTH = 4

N_MIXERS = 2
CONV_CHANNELS = D_MODEL
CONV_WIDTH = 31
HEAD_DIM = 64
HEADS_PER_GROUP = 4
DILATION_PAIRS = ((128, 1), (512, 4), (2048, 16))
N_GROUPS = len(DILATION_PAIRS)
N_HEADS = N_GROUPS * HEADS_PER_GROUP
D_ATTN = N_HEADS * HEAD_DIM
N_BUCKETS = 32
REL_MAX_DISTANCE = 2048
D_FF = -(-8 * D_MODEL // (3 * 256)) * 256
EPS = 1e-6
N_CONV_LAYERS = (DEPTH + 1) // 2
N_ATTN_LAYERS = DEPTH // 2
NEG_INF = -1e30

kernel_name = "hybrid_conv_dilated_attn_trunk"


def rmsnorm(x, g):
    x32 = x.astype(jnp.float32)
    y = x32 * lax.rsqrt(jnp.mean(x32 * x32, axis=-1, keepdims=True) + EPS)
    return (y * g.astype(jnp.float32)).astype(x.dtype)


def layernorm(x, g, b):
    x32 = x.astype(jnp.float32)
    mu = jnp.mean(x32, axis=-1, keepdims=True)
    xc = x32 - mu
    var = jnp.mean(xc * xc, axis=-1, keepdims=True)
    y = xc * lax.rsqrt(var + EPS) * g.astype(jnp.float32) + b.astype(jnp.float32)
    return y.astype(x.dtype)


def t5_bucket(dist):
    max_exact = N_BUCKETS // 2
    n = jnp.maximum(dist, 0)
    nf = jnp.maximum(n, 1).astype(jnp.float32)
    large = max_exact + (jnp.log(nf / max_exact) / math.log(REL_MAX_DISTANCE / max_exact)
                         * (N_BUCKETS - max_exact)).astype(jnp.int32)
    large = jnp.minimum(large, N_BUCKETS - 1)
    return jnp.where(n < max_exact, n, large)


def conformer_conv(h, w_pw1, b_pw1, w_dw, b_dw, ln_g, ln_b, w_pw2, b_pw2):
    u = h @ w_pw1 + b_pw1
    a, gate = jnp.split(u, 2, axis=-1)
    u = a * jax.nn.sigmoid(gate)
    u = lax.conv_general_dilated(
        u, w_dw[:, None, :], window_strides=(1,), padding=[(CONV_WIDTH - 1, 0)],
        dimension_numbers=("NWC", "WIO", "NWC"), feature_group_count=CONV_CHANNELS) + b_dw
    u = jax.nn.silu(layernorm(u, ln_g, ln_b))
    return u @ w_pw2 + b_pw2


def dilated_group(q, k, v, bias_table, window, dilation):
    b_, s, h, hd = q.shape
    n_back = window // dilation
    seg = n_back * dilation
    s_pad = -(-s // seg) * seg
    nb = s_pad // seg
    pad = ((0, 0), (0, s_pad - s), (0, 0), (0, 0))

    def blocks(t):
        return jnp.pad(t, pad).reshape(b_, nb, n_back, dilation, h, hd)

    def with_prev(t):
        prev = jnp.pad(t[:, :-1], ((0, 0), (1, 0), (0, 0), (0, 0), (0, 0), (0, 0)))
        return jnp.concatenate([prev, t], axis=2)

    qb = blocks(q)
    kk = with_prev(blocks(k))
    vv = with_prev(blocks(v))

    i_idx = jnp.arange(n_back)[:, None]
    j_idx = jnp.arange(2 * n_back)[None, :]
    dist = i_idx + n_back - j_idx
    bias = jnp.transpose(bias_table[t5_bucket(dist * dilation)], (2, 0, 1)).astype(jnp.float32)
    valid = (dist >= 0) & (dist <= n_back)
    not_before_start = (jnp.arange(nb)[:, None, None] > 0) | (j_idx[None] >= n_back)
    mask = valid[None] & not_before_start

    logits = jnp.einsum("bnidhc,bnjdhc->bndhij", qb, kk) * (HEAD_DIM ** -0.5) + bias
    logits = jnp.where(mask[None, :, None, None], logits, NEG_INF)
    m = jnp.max(logits, axis=-1, keepdims=True)
    p = jnp.exp(logits - m)
    den = jnp.sum(p, axis=-1)
    o = jnp.einsum("bndhij,bnjdhc->bnidhc", p, vv)
    den_t = jnp.transpose(den, (0, 1, 4, 2, 3))
    lse_t = jnp.transpose(m[..., 0] + jnp.log(den), (0, 1, 4, 2, 3))
    o = (o / den_t[..., None]).reshape(b_, s_pad, h, hd)[:, :s]
    lse = lse_t.reshape(b_, s_pad, h)[:, :s]
    return o, lse


def dilated_attention(h, w_qkv, w_o, rel_bias):
    b_, s, _ = h.shape
    qkv = (h @ w_qkv).astype(jnp.float32).reshape(b_, s, 3, N_HEADS, HEAD_DIM)
    outs, lses = [], []
    for g, (window, dilation) in enumerate(DILATION_PAIRS):
        hs = slice(g * HEADS_PER_GROUP, (g + 1) * HEADS_PER_GROUP)
        o, l = dilated_group(qkv[:, :, 0, hs], qkv[:, :, 1, hs], qkv[:, :, 2, hs],
                             rel_bias[:, hs], window, dilation)
        outs.append(o)
        lses.append(l)
    alpha = jax.nn.softmax(jnp.stack(lses, axis=0), axis=0)
    o = jnp.concatenate([outs[g] * alpha[g][..., None] for g in range(N_GROUPS)], axis=2)
    return o.reshape(b_, s, D_ATTN).astype(h.dtype) @ w_o


def swiglu(h, w_gate, w_up, w_down):
    return (jax.nn.silu(h @ w_gate) * (h @ w_up)) @ w_down


def setup_inputs(seed: int = 0) -> dict:
    key = jax.random.key(seed)
    ks = jax.random.split(key, 20)
    f32 = jnp.float32

    def nrm(k, shape, scale):
        return jax.random.normal(k, shape, f32) * scale

    return {
        "x": nrm(ks[0], (BATCH, SEQ, D_MODEL), 1.0),
        "norm_mix": 1.0 + nrm(ks[1], (DEPTH, D_MODEL), 0.05),
        "norm_ffn": 1.0 + nrm(ks[2], (DEPTH, D_MODEL), 0.05),
        "final_norm": 1.0 + nrm(ks[3], (D_MODEL,), 0.05),
        "conv_w_pw1": nrm(ks[4], (N_CONV_LAYERS, D_MODEL, 2 * CONV_CHANNELS), D_MODEL ** -0.5),
        "conv_b_pw1": nrm(ks[5], (N_CONV_LAYERS, 2 * CONV_CHANNELS), 0.01),
        "conv_w_dw": nrm(ks[6], (N_CONV_LAYERS, CONV_WIDTH, CONV_CHANNELS), CONV_WIDTH ** -0.5),
        "conv_b_dw": nrm(ks[7], (N_CONV_LAYERS, CONV_CHANNELS), 0.01),
        "conv_ln_g": 1.0 + nrm(ks[8], (N_CONV_LAYERS, CONV_CHANNELS), 0.05),
        "conv_ln_b": nrm(ks[9], (N_CONV_LAYERS, CONV_CHANNELS), 0.01),
        "conv_w_pw2": nrm(ks[10], (N_CONV_LAYERS, CONV_CHANNELS, D_MODEL), CONV_CHANNELS ** -0.5),
        "conv_b_pw2": nrm(ks[11], (N_CONV_LAYERS, D_MODEL), 0.01),
        "attn_w_qkv": nrm(ks[12], (N_ATTN_LAYERS, D_MODEL, 3 * D_ATTN), D_MODEL ** -0.5),
        "attn_w_o": nrm(ks[13], (N_ATTN_LAYERS, D_ATTN, D_MODEL), D_ATTN ** -0.5),
        "rel_bias": nrm(ks[14], (N_BUCKETS, N_HEADS), 0.5),
        "ffn_w_gate": nrm(ks[15], (DEPTH, D_MODEL, D_FF), D_MODEL ** -0.5),
        "ffn_w_up": nrm(ks[16], (DEPTH, D_MODEL, D_FF), D_MODEL ** -0.5),
        "ffn_w_down": nrm(ks[17], (DEPTH, D_FF, D_MODEL), D_FF ** -0.5),
    }


def reference(x, norm_mix, norm_ffn, final_norm, conv_w_pw1, conv_b_pw1, conv_w_dw, conv_b_dw,
              conv_ln_g, conv_ln_b, conv_w_pw2, conv_b_pw2, attn_w_qkv, attn_w_o, rel_bias,
              ffn_w_gate, ffn_w_up, ffn_w_down):
    for i in range(DEPTH):
        h = rmsnorm(x, norm_mix[i])
        j = i // N_MIXERS
        if i % N_MIXERS == 0:
            x = x + conformer_conv(h, conv_w_pw1[j], conv_b_pw1[j], conv_w_dw[j], conv_b_dw[j],
                                   conv_ln_g[j], conv_ln_b[j], conv_w_pw2[j], conv_b_pw2[j])
        else:
            x = x + dilated_attention(h, attn_w_qkv[j], attn_w_o[j], rel_bias)
        h = rmsnorm(x, norm_ffn[i])
        x = x + swiglu(h, ffn_w_gate[i], ffn_w_up[i], ffn_w_down[i])
    return rmsnorm(x, final_norm)
```

```cpp
#include <hip/hip_runtime.h>
#include <cstdio>
#include <cstdint>
#include <cmath>
namespace pg8 {
#define PG8_LAS __attribute__((address_space(3)))
typedef unsigned short bf16_t;
typedef short bf16x8 __attribute__((ext_vector_type(8)));
typedef float f32x4 __attribute__((ext_vector_type(4)));
typedef unsigned u32x4 __attribute__((ext_vector_type(4)));
constexpr int BM = 256, BK = 64, HALF = 128, HTB = HALF * BK * 2  , STAGE_BYTES = 8 * HTB, NXCD = 8, WGM = 8;

__host__ __device__ __forceinline__ int lds_byte(int r, int c) { const int st = (r >> 4) * 2 + (c >> 5), rr = r & 15, cc = c & 31, ob = rr * 64 + cc * 2; return st * 1024 + (ob ^ (((ob >> 9) & 1) << 5)); }
__host__ __device__ __forceinline__ void stage_rc(int b, int& R, int& C) { const int st = b / 1024, sb = b % 1024, swz = sb ^ (((sb >> 9) & 1) << 5); R = (st >> 1) * 16 + swz / 64; C = (st & 1) * 32 + (swz % 64) / 2; }
__host__ __device__ __forceinline__ int perm32(int rho) { const int n = rho >> 4, i = rho & 15; return 8 * (i >> 2) + 4 * n + (i & 3); }

struct Unit { int pm, pn; };
struct Gemm { const bf16_t* A; const bf16_t* Bt; int M, N, K; };

struct StaticOrder {
    int nM, nN, nwg, G, c;
    __host__ __device__ void init(int M, int N, int G_, int c_) { nM = M / BM; nN = N / BM; nwg = nM * nN; G = G_; c = c_; }
    __host__ __device__ bool next(int i, Unit& u) const {
        const long L = (long)i * G + c; if (L >= nwg) return false;
        int wgid = (int)L; { const int q = nwg / NXCD, r = nwg % NXCD, xcd = wgid % NXCD, off = wgid / NXCD; wgid = (xcd < r ? xcd * (q + 1) : r * (q + 1) + (xcd - r) * q) + off; }
        const int nig = WGM * nN, gid = wgid / nig, fm = gid * WGM, gsz = (nM - fm) < WGM ? (nM - fm) : WGM;
        u.pm = fm + ((wgid % nig) % gsz); u.pn = (wgid % nig) / gsz; return true;
    }
    __device__ __forceinline__ void a_ready(const Unit&) const {}
    __device__ __forceinline__ void done(const Unit&) const {}
};

__device__ __forceinline__ unsigned cvt_pk_bf16(float lo, float hi) { unsigned r; asm volatile("v_cvt_pk_bf16_f32 %0, %1, %2" : "=v"(r) : "v"(lo), "v"(hi)); return r; }
typedef float f32x2 __attribute__((ext_vector_type(2)));
typedef unsigned u32x2 __attribute__((ext_vector_type(2)));
constexpr float RMS_EPS = 1e-6f, INV_DM = 1.0f / 1024.0f, LOG2E_F = 1.4426950408889634f;
typedef unsigned long long ssq_t;
constexpr float SSQ_SCALE = 1073741824.0f, SSQ_INV = 1.0f / 1073741824.0f;
__device__ __forceinline__ ssq_t ssq_enc(float s) { return (ssq_t)(s * SSQ_SCALE); }
__device__ __forceinline__ float rstd_of(const ssq_t* p) { return __builtin_amdgcn_rsqf((float)(*p) * (SSQ_INV * INV_DM) + RMS_EPS); }
__device__ __forceinline__ float sigmoid_f(float x) { return __builtin_amdgcn_rcpf(1.0f + __builtin_amdgcn_exp2f(-LOG2E_F * x)); }

template <int MODE> struct EpiGate {
    static constexpr bool PERM = true, AFTER_DRAIN = false;
    bf16_t* O; int ldc; const ssq_t* ssq; const float* bias;
    __device__ __forceinline__ void operator()(const f32x4 (&acc)[2][2][4][2], const Unit& u, int wr, int wc, int fr, int fq) const {
        const int row0 = u.pm * BM + wr * 64 + fr, col0 = u.pn * HALF + wc * 32 + 8 * fq;
        f32x4 b0[2], b1[2];
#pragma unroll
        for (int n = 0; n < 2; ++n) {
            if (MODE == 0) { b0[n] = *(const f32x4*)(bias + col0 + 4 * n); b1[n] = *(const f32x4*)(bias + 1024 + col0 + 4 * n); }
            else { b0[n] = (f32x4){0.f, 0.f, 0.f, 0.f}; b1[n] = b0[n]; } }
#pragma unroll
        for (int ai = 0; ai < 2; ++ai)
#pragma unroll
            for (int m = 0; m < 4; ++m) { const int row = row0 + ai * HALF + m * 16;
                const float rs = rstd_of(ssq + row);
                u32x4 w; unsigned wv[4];
#pragma unroll
                for (int n = 0; n < 2; ++n) { const f32x4 p = acc[ai][0][m][n] * rs + b0[n], q = acc[ai][1][m][n] * rs + b1[n]; f32x4 o;
#pragma unroll
                    for (int i = 0; i < 4; ++i) o[i] = (MODE == 0) ? p[i] * sigmoid_f(q[i]) : (p[i] * sigmoid_f(p[i])) * q[i];
                    wv[2 * n] = cvt_pk_bf16(o[0], o[1]); wv[2 * n + 1] = cvt_pk_bf16(o[2], o[3]); }
                w.x = wv[0]; w.y = wv[1]; w.z = wv[2]; w.w = wv[3];
                *(u32x4*)(O + (size_t)row * ldc + col0) = w; }
    }
};
struct EpiQkv {
    static constexpr bool PERM = true, AFTER_DRAIN = false;
    bf16_t* O; int ldc; const ssq_t* ssq; int split_cols; size_t split_stride; float scale0;
    __device__ __forceinline__ void operator()(const f32x4 (&acc)[2][2][4][2], const Unit& u, int wr, int wc, int fr, int fq) const {
        const int row0 = u.pm * BM + wr * 64 + fr; int colt = u.pn * BM; bf16_t* base = O;
        float sc = 1.f; { const int t = colt / split_cols; base += (size_t)t * split_stride; colt -= t * split_cols; if (t == 0) sc = scale0; }
        const int col0 = colt + wc * 32 + 8 * fq;
#pragma unroll
        for (int ai = 0; ai < 2; ++ai)
#pragma unroll
            for (int m = 0; m < 4; ++m) { const int row = row0 + ai * HALF + m * 16;
                const float rs = rstd_of(ssq + row) * sc;
                bf16_t* rowp = base + (size_t)row * ldc + col0;
#pragma unroll
                for (int bj = 0; bj < 2; ++bj) { const f32x4 v0 = acc[ai][bj][m][0] * rs, v1 = acc[ai][bj][m][1] * rs;
                    u32x4 w; w.x = cvt_pk_bf16(v0[0], v0[1]); w.y = cvt_pk_bf16(v0[2], v0[3]); w.z = cvt_pk_bf16(v1[0], v1[1]); w.w = cvt_pk_bf16(v1[2], v1[3]);
                    *(u32x4*)(rowp + bj * HALF) = w; } }
    }
};
struct EpiResid {
    static constexpr bool PERM = false, AFTER_DRAIN = false;
    const float* base; float* out; bf16_t* xb; int ldc; const float* bias; ssq_t* ssq_out;
    __device__ __forceinline__ void operator()(const f32x4 (&acc)[2][2][4][2], const Unit& u, int wr, int wc, int fr, int fq) const {
        const int row0 = u.pm * BM + wr * 64 + fr, col0 = u.pn * BM + wc * 32 + 4 * fq;
        f32x4 bv[2][2];
#pragma unroll
        for (int bj = 0; bj < 2; ++bj)
#pragma unroll
            for (int n = 0; n < 2; ++n) bv[bj][n] = bias ? *(const f32x4*)(bias + col0 + bj * HALF + n * 16) : (f32x4){0.f, 0.f, 0.f, 0.f};
        unsigned eoff = (unsigned)row0 * (unsigned)ldc + (unsigned)col0;
#pragma unroll
        for (int ai = 0; ai < 2; ++ai)
#pragma unroll
            for (int m = 0; m < 4; ++m) { asm volatile("" : "+v"(eoff));
                const int row = row0 + ai * HALF + m * 16; float s = 0.f;
                const float* bp = base + eoff; float* op = out + eoff; bf16_t* xp = xb + eoff;
#pragma unroll
                for (int bj = 0; bj < 2; ++bj)
#pragma unroll
                    for (int n = 0; n < 2; ++n) { const f32x4 bs = *(const f32x4*)(bp + bj * HALF + n * 16); const f32x4 o = bs + acc[ai][bj][m][n] + bv[bj][n];
                        *(f32x4*)(op + bj * HALF + n * 16) = o;
                        u32x2 w; w.x = cvt_pk_bf16(o[0], o[1]); w.y = cvt_pk_bf16(o[2], o[3]); *(u32x2*)(xp + bj * HALF + n * 16) = w;
                        s += (o[0] * o[0] + o[1] * o[1]) + (o[2] * o[2] + o[3] * o[3]); }
                s += __shfl_xor(s, 16); s += __shfl_xor(s, 32);
                if (fq == 0) atomicAdd(ssq_out + row, ssq_enc(s));
                eoff += (m == 3 ? (HALF - 48) : 16) * (unsigned)ldc;
                asm volatile("" ::: "memory"); }
    }
};
template <class Epi, class Sched, bool ALIGN_EPI = false, bool SP2 = false>
__device__ __forceinline__ void gemm_phase(PG8_LAS unsigned char* lds, const Gemm g, const Sched& S, const Epi& E) {
    int tid = threadIdx.x; asm volatile("" : "+v"(tid));
    const int wid = __builtin_amdgcn_readfirstlane(tid >> 6), lane = tid & 63, wr = wid >> 2, wc = wid & 3, fr = lane & 15, fq = lane >> 4;
    const int K = g.K, nt = K / BK;
    unsigned voffA[2], voffB[2];
#pragma unroll
    for (int i = 0; i < 2; ++i) { int R, C; stage_rc(tid * 16 + i * 8192, R, C); const int Rb = Epi::PERM ? ((R & ~31) + perm32(R & 31)) : R;
        voffA[i] = (unsigned)(R * K + C) * 2u; voffB[i] = (unsigned)(Rb * K + C) * 2u; }
    const size_t kstep = (size_t)(BK * 2);
    const size_t hstep = (size_t)HALF * K * 2;
    const size_t tstep = 2 * hstep;
    const unsigned ldsw = (unsigned)wid * 1024u;
    const int aoff = lds_byte(wr * 64 + fr, fq * 8), boff = lds_byte(wc * 32 + fr, fq * 8);
#define PG8_SA(b, h) (((b) * 2 + (h)) * HTB)
#define PG8_SB(b, h) ((4 + (b) * 2 + (h)) * HTB)
#define PG8_STAGE(bufoff, gbase, voff) do { _Pragma("unroll") for (int _i = 0; _i < 2; ++_i) \
        __builtin_amdgcn_global_load_lds((const unsigned*)((const char*)(gbase) + (voff)[_i]), (PG8_LAS unsigned*)(lds + (bufoff) + ldsw + _i * 8192), 16, 0, 0); } while (0)
#define PG8_LDA(dst, b, h) do { _Pragma("unroll") for (int m = 0; m < 4; ++m) _Pragma("unroll") for (int k = 0; k < 2; ++k) dst[m][k] = *(const PG8_LAS bf16x8*)(lds + PG8_SA(b, h) + aoff + m * 2048 + k * 1024); } while (0)
#define PG8_LDB(dst, b, h) do { _Pragma("unroll") for (int n = 0; n < 2; ++n) _Pragma("unroll") for (int k = 0; k < 2; ++k) dst[n][k] = *(const PG8_LAS bf16x8*)(lds + PG8_SB(b, h) + boff + n * 2048 + k * 1024); } while (0)
#define PG8_MMA(ai, bj, At, Bt) do { __builtin_amdgcn_s_setprio(1); _Pragma("unroll") for (int m = 0; m < 4; ++m) _Pragma("unroll") for (int n = 0; n < 2; ++n) _Pragma("unroll") for (int k = 0; k < 2; ++k) \
        acc[ai][bj][m][n] = __builtin_amdgcn_mfma_f32_16x16x32_bf16(Bt[n][k], At[m][k], acc[ai][bj][m][n], 0, 0, 0); __builtin_amdgcn_s_setprio(0); } while (0)
#define PG8_WAIT_V(n) asm volatile("s_waitcnt vmcnt(" #n ")" ::: "memory")
#define PG8_WAIT_L(n) asm volatile("s_waitcnt lgkmcnt(" #n ")" ::: "memory")
#define PG8_BAR __builtin_amdgcn_s_barrier()
#define PG8_SCHED __builtin_amdgcn_sched_barrier(0)
    Unit cur, nxt; int ui = 0;
    if (!S.next(0, cur)) return;
    f32x4 acc[2][2][4][2];
#pragma unroll
    for (int a = 0; a < 2; ++a)
#pragma unroll
        for (int b = 0; b < 2; ++b)
#pragma unroll
            for (int m = 0; m < 4; ++m)
#pragma unroll
                for (int n = 0; n < 2; ++n) acc[a][b][m][n] = (f32x4){0.f, 0.f, 0.f, 0.f};
    bf16x8 At[4][2], B0[2][2], B1[2][2];
    const char* cA = (const char*)g.A + (size_t)cur.pm * tstep; const char* cB = (const char*)g.Bt + (size_t)cur.pn * tstep;
    S.a_ready(cur);
    if constexpr (SP2) {
        PG8_STAGE(PG8_SB(0, 0), cB, voffB); PG8_STAGE(PG8_SB(0, 1), cB + hstep, voffB); PG8_STAGE(PG8_SA(0, 0), cA, voffA); PG8_STAGE(PG8_SA(0, 1), cA + hstep, voffA);
        if (wr == 1) PG8_BAR;
        PG8_WAIT_V(2); PG8_BAR;
        PG8_STAGE(PG8_SB(1, 0), cB + kstep, voffB); PG8_STAGE(PG8_SA(1, 0), cA + kstep, voffA); PG8_STAGE(PG8_SB(1, 1), cB + hstep + kstep, voffB);
        PG8_WAIT_V(6); PG8_BAR;
    } else {
        PG8_STAGE(PG8_SB(0, 0), cB, voffB); PG8_STAGE(PG8_SA(0, 0), cA, voffA); PG8_STAGE(PG8_SB(0, 1), cB + hstep, voffB); PG8_STAGE(PG8_SA(0, 1), cA + hstep, voffA);
        if (wr == 1) PG8_BAR;
        PG8_WAIT_V(4); PG8_BAR;
        PG8_STAGE(PG8_SB(1, 0), cB + kstep, voffB); PG8_STAGE(PG8_SA(1, 0), cA + kstep, voffA); PG8_STAGE(PG8_SB(1, 1), cB + hstep + kstep, voffB);
        PG8_WAIT_V(6); PG8_BAR;
    }
    for (;;) {
        const bool has_next = S.next(ui + 1, nxt);
        const char* nA = has_next ? (const char*)g.A + (size_t)nxt.pm * tstep : cA; const char* nB = has_next ? (const char*)g.Bt + (size_t)nxt.pn * tstep : cB;
        for (int t = 0; t < nt; t += 2) {
            const bool last = (t == nt - 2);
            const char* a1 = cA + (size_t)(t + 1) * kstep;
            const char* a2 = last ? nA : cA + (size_t)(t + 2) * kstep; const char* b2 = last ? nB : cB + (size_t)(t + 2) * kstep;
            const char* a3 = a2 + kstep; const char* b3 = b2 + kstep;
            if (last && has_next) S.a_ready(nxt);
            if constexpr (SP2) {
            PG8_LDB(B0, 0, 0); PG8_LDB(B1, 0, 1); PG8_SCHED; PG8_LDA(At, 0, 0); PG8_STAGE(PG8_SA(1, 1), a1 + hstep, voffA);
            PG8_WAIT_V(8); PG8_WAIT_L(0); PG8_BAR; PG8_MMA(0, 0, At, B0); PG8_MMA(0, 1, At, B1); PG8_BAR; PG8_SCHED;
            PG8_LDA(At, 0, 1); PG8_STAGE(PG8_SB(0, 0), b2, voffB); PG8_STAGE(PG8_SB(0, 1), b2 + hstep, voffB); PG8_STAGE(PG8_SA(0, 0), a2, voffA);
            PG8_WAIT_V(8); PG8_WAIT_L(0); PG8_BAR; PG8_MMA(1, 0, At, B0); PG8_MMA(1, 1, At, B1); PG8_BAR; PG8_SCHED;
            PG8_LDB(B0, 1, 0); PG8_LDB(B1, 1, 1); PG8_SCHED; PG8_LDA(At, 1, 0); PG8_STAGE(PG8_SA(0, 1), a2 + hstep, voffA);
            PG8_WAIT_V(8); PG8_WAIT_L(0); PG8_BAR; PG8_MMA(0, 0, At, B0); PG8_MMA(0, 1, At, B1); PG8_BAR; PG8_SCHED;
            PG8_LDA(At, 1, 1); PG8_STAGE(PG8_SB(1, 0), b3, voffB); PG8_STAGE(PG8_SB(1, 1), b3 + hstep, voffB); PG8_STAGE(PG8_SA(1, 0), a3, voffA);
            PG8_WAIT_V(8); PG8_WAIT_L(0); PG8_BAR; PG8_MMA(1, 0, At, B0); PG8_MMA(1, 1, At, B1); PG8_BAR; PG8_SCHED;
            } else {
            PG8_LDB(B0, 0, 0); PG8_SCHED; PG8_LDA(At, 0, 0); PG8_STAGE(PG8_SA(1, 1), a1 + hstep, voffA);
            PG8_WAIT_L(8); PG8_BAR; PG8_WAIT_L(0); PG8_MMA(0, 0, At, B0); PG8_BAR; PG8_SCHED;
            PG8_LDB(B1, 0, 1); PG8_STAGE(PG8_SB(0, 0), b2, voffB);
            PG8_BAR; PG8_WAIT_L(0); PG8_MMA(0, 1, At, B1); PG8_BAR;
            PG8_LDA(At, 0, 1); PG8_STAGE(PG8_SA(0, 0), a2, voffA);
            PG8_BAR; PG8_WAIT_L(0); PG8_MMA(1, 0, At, B0); PG8_BAR; PG8_SCHED;
            PG8_STAGE(PG8_SB(0, 1), b2 + hstep, voffB);
            PG8_WAIT_V(6); PG8_BAR; PG8_MMA(1, 1, At, B1); PG8_BAR;
            PG8_LDB(B0, 1, 0); PG8_SCHED; PG8_LDA(At, 1, 0); PG8_STAGE(PG8_SA(0, 1), a2 + hstep, voffA);
            PG8_WAIT_L(8); PG8_BAR; PG8_WAIT_L(0); PG8_MMA(0, 0, At, B0); PG8_BAR; PG8_SCHED;
            PG8_LDB(B1, 1, 1); PG8_STAGE(PG8_SB(1, 0), b3, voffB);
            PG8_BAR; PG8_WAIT_L(0); PG8_MMA(0, 1, At, B1); PG8_BAR;
            PG8_LDA(At, 1, 1); PG8_STAGE(PG8_SA(1, 0), a3, voffA);
            PG8_BAR; PG8_WAIT_L(0); PG8_MMA(1, 0, At, B0); PG8_BAR; PG8_SCHED;
            PG8_STAGE(PG8_SB(1, 1), b3 + hstep, voffB);
            PG8_WAIT_V(6); PG8_BAR; PG8_MMA(1, 1, At, B1); PG8_BAR;
            }
        }
        if constexpr (ALIGN_EPI) { if (wr == 0) PG8_BAR; }
        if constexpr (!Epi::AFTER_DRAIN) { E(acc, cur, wr, wc, fr, fq); S.done(cur); }
        if (!has_next) break;
#pragma unroll
        for (int a = 0; a < 2; ++a)
#pragma unroll
            for (int b = 0; b < 2; ++b)
#pragma unroll
                for (int m = 0; m < 4; ++m)
#pragma unroll
                    for (int n = 0; n < 2; ++n) acc[a][b][m][n] = (f32x4){0.f, 0.f, 0.f, 0.f};
        cur = nxt; cA = nA; cB = nB; ++ui;
        if constexpr (ALIGN_EPI) { if (wr == 1) PG8_BAR; }
    }
    PG8_WAIT_V(0);
    if constexpr (!ALIGN_EPI) { if (wr == 0) PG8_BAR; }
    PG8_BAR;
    if constexpr (Epi::AFTER_DRAIN) { E.fused(acc, cur, wr, wc, fr, fq, lds, wid, lane); S.done(cur); }
#undef PG8_SA
#undef PG8_SB
#undef PG8_STAGE
#undef PG8_LDA
#undef PG8_LDB
#undef PG8_MMA
#undef PG8_WAIT_V
#undef PG8_WAIT_L
#undef PG8_BAR
#undef PG8_SCHED
}
}
namespace dattn {
typedef short bf16x8 __attribute__((ext_vector_type(8)));
typedef short s16x4 __attribute__((ext_vector_type(4)));
typedef float f32x16 __attribute__((ext_vector_type(16)));
typedef unsigned u32x4 __attribute__((ext_vector_type(4)));
#define DA_LAS __attribute__((address_space(3)))
constexpr int SEQ = 8192, NH = 12, HD = 64, DA = NH * HD, NKEY = 384, KROW = 144;
constexpr int LDS_K = 0, K_BYTES = NKEY * KROW, LDS_V = K_BYTES, V_HALF = NKEY * 64, LDS_BIAS = LDS_V + 2 * V_HALF, LDS_WS = LDS_BIAS + 1024, LDS_OST = LDS_WS + 8 * 256, LDS_END = LDS_OST + 8 * 4096;
constexpr int NUNITS = 2 * NH * 32;
__device__ const unsigned char T5_BUCKET[3][132] = {
 {0,1,2,3,4,5,6,7,8,9,10,11,12,13,14,15,16,16,16,16,16,16,17,17,17,17,17,17,17,17,18,18,18,18,18,18,18,18,18,18,19,19,19,19,19,19,19,19,19,19,19,19,19,19,20,20,20,20,20,20,20,20,20,20,20,20,20,20,20,20,20,20,20,21,21,21,21,21,21,21,21,21,21,21,21,21,21,21,21,21,21,21,21,21,21,21,21,21,21,22,22,22,22,22,22,22,22,22,22,22,22,22,22,22,22,22,22,22,22,22,22,22,22,22,22,22,22,22,22,0,0,0},
 {0,4,8,12,16,16,17,17,18,18,19,19,19,19,20,20,20,20,20,21,21,21,21,21,21,22,22,22,22,22,22,22,22,22,23,23,23,23,23,23,23,23,23,23,23,23,24,24,24,24,24,24,24,24,24,24,24,24,24,24,24,24,25,25,25,25,25,25,25,25,25,25,25,25,25,25,25,25,25,25,25,25,25,26,26,26,26,26,26,26,26,26,26,26,26,26,26,26,26,26,26,26,26,26,26,26,26,26,26,26,26,26,26,27,27,27,27,27,27,27,27,27,27,27,27,27,27,27,27,0,0,0},
 {0,16,18,19,20,21,21,22,22,23,23,23,24,24,24,24,25,25,25,25,25,26,26,26,26,26,26,26,26,27,27,27,27,27,27,27,27,27,27,28,28,28,28,28,28,28,28,28,28,28,28,28,29,29,29,29,29,29,29,29,29,29,29,29,29,29,29,29,29,29,30,30,30,30,30,30,30,30,30,30,30,30,30,30,30,30,30,30,30,30,30,30,30,30,30,31,31,31,31,31,31,31,31,31,31,31,31,31,31,31,31,31,31,31,31,31,31,31,31,31,31,31,31,31,31,31,31,31,31,0,0,0}};
__device__ __forceinline__ int crow(int r, int hi) { return (r & 3) + 8 * (r >> 2) + 4 * hi; }
__device__ __forceinline__ unsigned cvtpk(float lo, float hi) { unsigned r; asm volatile("v_cvt_pk_bf16_f32 %0, %1, %2" : "=v"(r) : "v"(lo), "v"(hi)); return r; }
typedef short v4i16_t __attribute__((ext_vector_type(4)));
__device__ __forceinline__ s16x4 vtr(DA_LAS const char* p) { return __builtin_bit_cast(s16x4, __builtin_amdgcn_ds_read_tr16_b64_v4i16((DA_LAS v4i16_t*)p)); }

__device__ __forceinline__ void attn_unit(int unit, const unsigned short* Q, const unsigned short* K, const unsigned short* V, unsigned short* O, float* lse2, const float* rel_bias, DA_LAS char* lds) {
    int tid = threadIdx.x; asm volatile("" : "+v"(tid));
    const int lane = tid & 63, q32 = lane & 31, hi = lane >> 5; const int wid = __builtin_amdgcn_readfirstlane(tid >> 6);
    const int bh = unit >> 5, u32i = unit & 31, b = bh / NH, h = bh % NH, g = h >> 2;
    const int dsh = 2 * g;
    const int cps = 32 >> dsh;
    const int r = u32i / cps, chunk = u32i % cps, I0 = chunk * 256;
    const size_t rowbase = (size_t)b * SEQ;
#pragma unroll
    for (int it = 0; it < 6; ++it) { const int idx = tid + 512 * it, row = idx >> 3, ch = idx & 7, J = I0 - 128 + row;
        u32x4 kv = (u32x4){0u, 0u, 0u, 0u}, vv = kv;
        if (J >= 0) { const size_t ga = (rowbase + (size_t)((J << dsh) + r)) * DA + h * HD + ch * 8; kv = *(const u32x4*)(K + ga); vv = *(const u32x4*)(V + ga); }
        *(DA_LAS u32x4*)(lds + LDS_K + row * KROW + ch * 16) = kv;
        *(DA_LAS u32x4*)(lds + LDS_V + (ch >> 2) * V_HALF + row * 64 + (ch & 3) * 16) = vv; }
    if (tid < 132) { const int bk = T5_BUCKET[g][tid]; ((DA_LAS float*)(lds + LDS_BIAS))[tid] = rel_bias[bk * NH + h] * 1.4426950408889634f; }
    __syncthreads();
    const int Iq = I0 + 32 * wid + q32;
    const size_t qtok = rowbase + (size_t)((Iq << dsh) + r);
    bf16x8 qr[4];
#pragma unroll
    for (int s = 0; s < 4; ++s) qr[s] = *(const bf16x8*)(Q + qtok * DA + h * HD + s * 16 + hi * 8);
    f32x16 st[5];
#pragma unroll
    for (int kt = 0; kt < 5; ++kt) { const DA_LAS char* kp = lds + LDS_K + (32 * (wid + kt) + q32) * KROW + hi * 16;
        f32x16 a = {};
#pragma unroll
        for (int s = 0; s < 4; ++s) { const bf16x8 kf = *(const DA_LAS bf16x8*)(kp + s * 32); a = __builtin_amdgcn_mfma_f32_32x32x16_bf16(kf, qr[s], a, 0, 0, 0); }
        st[kt] = a; }
    const DA_LAS float* bias = (const DA_LAS float*)(lds + LDS_BIAS);
    const float NEG = -INFINITY; float mx = NEG;
    const int Jw = I0 + 32 * wid - 128;
#pragma unroll
    for (int kt = 0; kt < 5; ++kt) { const bool tile_ok = (Jw + 32 * kt) >= 0;
#pragma unroll
        for (int i = 0; i < 16; ++i) { const int rho = crow(i, hi); const int dist = 128 - 32 * kt + q32 - rho;
            bool ok = tile_ok; if (kt == 0) ok = ok && (rho >= q32); if (kt == 4) ok = ok && (rho <= q32);
            const int dc = (kt == 0) ? (dist > 128 ? 128 : dist) : ((kt == 4) ? (dist < 0 ? 0 : dist) : dist);
            const float v = ok ? st[kt][i] + bias[dc] : NEG; st[kt][i] = v; mx = __builtin_fmaxf(mx, v); } }
    { auto rr = __builtin_amdgcn_permlane32_swap(__float_as_uint(mx), __float_as_uint(mx), false, false); mx = __builtin_fmaxf(__uint_as_float(rr[0]), __uint_as_float(rr[1])); }
    float den = 0.f;
#pragma unroll
    for (int kt = 0; kt < 5; ++kt)
#pragma unroll
        for (int i = 0; i < 16; ++i) { const float p = __builtin_amdgcn_exp2f(st[kt][i] - mx); st[kt][i] = p; den += p; }
    { auto rr = __builtin_amdgcn_permlane32_swap(__float_as_uint(den), __float_as_uint(den), false, false); den = __uint_as_float(rr[0]) + __uint_as_float(rr[1]); }
    f32x16 o[2]; o[0] = f32x16{}; o[1] = f32x16{};
    const DA_LAS char* vp0 = lds + LDS_V + (32 * wid + 4 * hi + ((lane >> 2) & 3)) * 64 + ((lane >> 4) & 1) * 32 + (lane & 3) * 8;
#pragma unroll
    for (int kt = 0; kt < 5; ++kt)
#pragma unroll
        for (int s2 = 0; s2 < 2; ++s2) { u32x4 pw; pw.x = cvtpk(st[kt][8 * s2 + 0], st[kt][8 * s2 + 1]); pw.y = cvtpk(st[kt][8 * s2 + 2], st[kt][8 * s2 + 3]); pw.z = cvtpk(st[kt][8 * s2 + 4], st[kt][8 * s2 + 5]); pw.w = cvtpk(st[kt][8 * s2 + 6], st[kt][8 * s2 + 7]);
            const bf16x8 pa = __builtin_bit_cast(bf16x8, pw);
#pragma unroll
            for (int dh = 0; dh < 2; ++dh) { const DA_LAS char* vp = vp0 + dh * V_HALF + (32 * kt + 16 * s2) * 64;
                const s16x4 lo = vtr(vp), hv = vtr(vp + 8 * 64);
                const bf16x8 vf = (bf16x8){lo[0], lo[1], lo[2], lo[3], hv[0], hv[1], hv[2], hv[3]};
                o[dh] = __builtin_amdgcn_mfma_f32_32x32x16_bf16(pa, vf, o[dh], 0, 0, 0); } }
    DA_LAS float* wsf = (DA_LAS float*)(lds + LDS_WS) + wid * 64;
    if (hi == 0) { wsf[q32] = __builtin_amdgcn_rcpf(den); lse2[qtok * NH + h] = mx + __builtin_amdgcn_logf(den); }
    asm volatile("s_waitcnt lgkmcnt(0)" ::: "memory");
    DA_LAS unsigned short* stg = (DA_LAS unsigned short*)(lds + LDS_OST) + wid * 2048;
#pragma unroll
    for (int i = 0; i < 16; ++i) { const int orow = crow(i, hi); const float rl = wsf[orow];
#pragma unroll
        for (int dh = 0; dh < 2; ++dh) { const unsigned pk = cvtpk(o[dh][i] * rl, 0.f); stg[orow * 64 + dh * 32 + q32] = (unsigned short)(pk & 0xffffu); } }
    asm volatile("s_waitcnt lgkmcnt(0)" ::: "memory");
#pragma unroll
    for (int i = 0; i < 4; ++i) { const int row = i * 8 + (lane >> 3), ch = lane & 7; const u32x4 v = *(const DA_LAS u32x4*)(stg + row * 64 + ch * 8);
        const size_t otok = rowbase + (size_t)(((I0 + 32 * wid + row) << dsh) + r);
        *(u32x4*)(O + otok * DA + h * HD + ch * 8) = v; }
    __syncthreads();
}
__device__ __forceinline__ void scale_rows(unsigned short* O, const float* lse2, int gw, int ngw, int lane) {
    for (int m = gw; m < 2 * SEQ; m += ngw) {
        const float* l = lse2 + (size_t)m * NH;
#pragma unroll
        for (int k = 0; k < 3; ++k) { const int c = lane + 64 * k, head = c >> 4, hh = head & 3, g = head >> 2;
            const float l0 = l[hh], l1 = l[4 + hh], l2 = l[8 + hh]; const float mm = __builtin_fmaxf(__builtin_fmaxf(l0, l1), l2);
            const float e0 = __builtin_amdgcn_exp2f(l0 - mm), e1 = __builtin_amdgcn_exp2f(l1 - mm), e2 = __builtin_amdgcn_exp2f(l2 - mm);
            const float a = (g == 0 ? e0 : (g == 1 ? e1 : e2)) * __builtin_amdgcn_rcpf(e0 + e1 + e2);
            unsigned long long* p = (unsigned long long*)(O + (size_t)m * DA) + c; const unsigned long long w = *p;
            const unsigned w0 = (unsigned)w, w1 = (unsigned)(w >> 32);
            const float f0 = __uint_as_float(w0 << 16) * a, f1 = __uint_as_float(w0 & 0xffff0000u) * a, f2 = __uint_as_float(w1 << 16) * a, f3 = __uint_as_float(w1 & 0xffff0000u) * a;
            *p = (unsigned long long)cvtpk(f0, f1) | ((unsigned long long)cvtpk(f2, f3) << 32); }
    }
}
}
#define GAS __attribute__((address_space(1)))
#define LAS __attribute__((address_space(3)))
typedef unsigned short bf16;
typedef unsigned v4u __attribute__((ext_vector_type(4)));
typedef float f32x4 __attribute__((ext_vector_type(4)));
typedef short bf16x8 __attribute__((ext_vector_type(8)));
typedef GAS unsigned gu32;
typedef GAS unsigned long long gu64;
#define RLX_AGENT __ATOMIC_RELAXED, __HIP_MEMORY_SCOPE_AGENT
#define LDS_WAIT() asm volatile("s_waitcnt lgkmcnt(0)" ::: "memory")
#define VM_WAIT() asm volatile("s_waitcnt vmcnt(0)" ::: "memory")
__device__ __forceinline__ unsigned long long rt() { return __builtin_amdgcn_s_memrealtime(); }
__device__ __forceinline__ unsigned f2bf(float f) { unsigned u = __builtin_bit_cast(unsigned, f); return (u + 0x7fffu + ((u >> 16) & 1u)) >> 16; }
__device__ __forceinline__ unsigned pk2(float lo, float hi) { return f2bf(lo) | (f2bf(hi) << 16); }

#define XB_TMO      128
#define XB_XCNT(j)  (256  + 64 * (j))
#define XB_XSUB(j)  (1280 + 64 * (j))
#define XB_XGEN(j)  (2304 + 64 * (j))
#define XB_TOP      3328
#define XB_TOPGEN   3392
#define XCD_BAR_WORDS 3456
#define XB_SPIN_CAP (1u << 18)

__device__ __forceinline__ unsigned xb_ld(unsigned* p)              { return __hip_atomic_load(p, __ATOMIC_RELAXED, __HIP_MEMORY_SCOPE_AGENT); }
__device__ __forceinline__ unsigned xb_add(unsigned* p, unsigned v) { return __hip_atomic_fetch_add(p, v, __ATOMIC_RELAXED, __HIP_MEMORY_SCOPE_AGENT); }
__device__ __forceinline__ unsigned xb_xcc_id() { return (unsigned)__builtin_amdgcn_s_getreg((3 << 11) | 20) & 0xFu; }
#define XB_SPIN(cond, bar) do { unsigned _sp = 0; while (cond) { __builtin_amdgcn_s_sleep(1); \
    if ((++_sp & 255u) == 0u) { if (xb_ld(&(bar)[XB_TMO])) break; if (_sp > XB_SPIN_CAP) { atomicAdd(&(bar)[XB_TMO], 1u); break; } } } } while (0)

struct XcdBarrier {
    unsigned* bar; unsigned x;
    volatile LAS unsigned* st;
};

__device__ __forceinline__ XcdBarrier xcd_barrier_post(unsigned* bar, volatile LAS unsigned* st) {
    XcdBarrier b; b.bar = bar; b.x = xb_xcc_id(); b.st = st;
    if (threadIdx.x == 0) (void)xb_add(&bar[XB_XCNT(b.x)], 1u);
    return b;
}
__device__ __forceinline__ void xcd_barrier_complete(unsigned* bar, unsigned x, unsigned& nloc, unsigned& nx) {
    const unsigned G = gridDim.x * gridDim.y * gridDim.z;
    unsigned sum, cnt, mine, sp = 0u;
    for (;;) {
        sum = 0u; cnt = 0u; mine = 0u;
#pragma unroll
        for (unsigned j = 0; j < 16; ++j) { const unsigned c = xb_ld(&bar[XB_XCNT(j)]); sum += c; cnt += (c > 0u) ? 1u : 0u; mine = (j == x) ? c : mine; }
        if (sum == G) break;
        __builtin_amdgcn_s_sleep(1);
        if ((++sp & 255u) == 0u) { if (xb_ld(&bar[XB_TMO])) break; if (sp > XB_SPIN_CAP) { atomicAdd(&bar[XB_TMO], 1u); break; } }
    }
    nloc = mine > 0u ? mine : 1u; nx = cnt > 0u ? cnt : 1u;
}

__device__ __forceinline__ void xcd_barrier(const XcdBarrier& b) {
    asm volatile("s_waitcnt vmcnt(0)" ::: "memory");
    __syncthreads();
    if (threadIdx.x == 0) {
        unsigned* bar = b.bar;
        __builtin_amdgcn_s_waitcnt(0);
        unsigned nloc = b.st[0], nx = b.st[1];
        if (nloc == 0u) { xcd_barrier_complete(bar, b.x, nloc, nx); b.st[0] = nloc; b.st[1] = nx; }
        const unsigned old = xb_add(&bar[XB_XSUB(b.x)], 1u);
        const unsigned gen = old / nloc;
        if (old + 1u == (gen + 1u) * nloc) {
            __builtin_amdgcn_fence(__ATOMIC_RELEASE, "agent");
            asm volatile("s_waitcnt vmcnt(0)" ::: "memory");
            const unsigned og = xb_add(&bar[XB_TOP], 1u);
            const unsigned tg = og / nx;
            if (og + 1u == (tg + 1u) * nx) xb_add(&bar[XB_TOPGEN], 1u);
            else XB_SPIN(xb_ld(&bar[XB_TOPGEN]) == tg, bar);
            __builtin_amdgcn_fence(__ATOMIC_ACQUIRE, "agent");
            xb_add(&bar[XB_XGEN(b.x)], 1u);
            asm volatile("s_waitcnt vmcnt(0)" ::: "memory");
        } else {
            XB_SPIN(xb_ld(&bar[XB_XGEN(b.x)]) == gen, bar);
            __builtin_amdgcn_fence(__ATOMIC_ACQUIRE, "agent");
            asm volatile("s_waitcnt vmcnt(0)" ::: "memory");
        }
    }
    __syncthreads();
}
constexpr int NWAVES = 8;
constexpr int BATCH = 2, SEQ = 8192, DM = 1024, M = BATCH * SEQ, DEPTH = 4, CONVW = 31, DATT = 768, NHEADS = 12, DFF = 2816;
constexpr size_t MiB = 1u << 20;
constexpr size_t WS_CTL = 0, CTL_ZERO_BYTES = 4 * MiB;
constexpr size_t WS_SSQ = 1 * MiB;
constexpr size_t WS_WPW1 = 4 * MiB, WS_WPW2 = 12 * MiB, WS_WQKV = 16 * MiB, WS_WO = 25 * MiB, WS_WGU = 28 * MiB, WS_WDN = 72 * MiB;
constexpr size_t WS_XB = 94 * MiB;
constexpr size_t WS_R = 126 * MiB;
constexpr size_t WS_LSE = 214 * MiB, WS_END = 215 * MiB;
constexpr int CW_BAR = 4096;
constexpr int RING_BYTES = 131072, LDS_BYTES = 147456, MISC_OFF = LDS_BYTES - 256, STATS_OFF = 131072;
static_assert(dattn::LDS_END <= MISC_OFF, "attention LDS map");

__device__ __forceinline__ float wave_sum(float v) {
#pragma unroll
    for (int o = 1; o < 64; o <<= 1) v += __shfl_xor(v, o);
    return v;
}
__device__ __forceinline__ void transpose_item(const float* W, int ldw, int c0, int k0, const float* gain, bf16* WT, int K, int r0, LAS float* scr, int lane) {
#pragma unroll 8
    for (int i = 0; i < 32; ++i) { const int kk = 2 * i + (lane >> 5); float w = W[(size_t)(k0 + kk) * ldw + c0 + (lane & 31)]; if (gain) w *= gain[k0 + kk]; scr[kk * 33 + (lane & 31)] = w; }
    LDS_WAIT(); asm volatile("" ::: "memory");
    const int c = lane & 7;
#pragma unroll
    for (int j = 0; j < 4; ++j) { const int n = (lane >> 3) + 8 * j; const LAS float* s = scr + (8 * c) * 33 + n;
        v4u o; o.x = pk2(s[0 * 33], s[1 * 33]); o.y = pk2(s[2 * 33], s[3 * 33]); o.z = pk2(s[4 * 33], s[5 * 33]); o.w = pk2(s[6 * 33], s[7 * 33]);
        *(GAS v4u*)(WT + (size_t)(r0 + n) * K + k0 + 8 * c) = o; }
    LDS_WAIT(); asm volatile("" ::: "memory");
}

struct Args { const float* in[18]; float* out; unsigned char* ws; int ph_lo, ph_hi; };

__device__ __forceinline__ void prologue(const Args& a, LAS unsigned char* lds, int gw, int ngw, int wave, int lane) {
    LAS float* scr = (LAS float*)(lds + wave * 16384);
    unsigned char* ws = a.ws;
    const float* norm_mix = a.in[1]; const float* norm_ffn = a.in[2];
    constexpr int I_PW1 = 16 * 64, I_PW2 = 16 * 32, I_QKV = 16 * 72, I_WO = 12 * 32, I_GU = 16 * 176, I_DN = 44 * 32;
    constexpr int NITEMS = 2 * (I_PW1 + I_PW2 + I_QKV + I_WO) + 4 * (I_GU + I_DN);
    for (int it = gw; it < NITEMS; it += ngw) {
        int r = it;
        if (r < 2 * I_PW1) { const int j = r / I_PW1; r -= j * I_PW1; const int kb = r >> 6, nb = r & 63, n0 = nb * 32;
            const int src = ((n0 >> 7) & 1) * 1024 + (n0 >> 8) * 128 + (n0 & 127);
            transpose_item(a.in[4] + (size_t)j * 1024 * 2048, 2048, src, kb * 64, norm_mix + (2 * j) * DM, (bf16*)(ws + WS_WPW1) + (size_t)j * 2048 * 1024, 1024, n0, scr, lane); continue; } r -= 2 * I_PW1;
        if (r < 2 * I_PW2) { const int j = r / I_PW2; r -= j * I_PW2; const int kb = r >> 5, nb = r & 31;
            transpose_item(a.in[10] + (size_t)j * 1024 * 1024, 1024, nb * 32, kb * 64, nullptr, (bf16*)(ws + WS_WPW2) + (size_t)j * 1024 * 1024, 1024, nb * 32, scr, lane); continue; } r -= 2 * I_PW2;
        if (r < 2 * I_QKV) { const int j = r / I_QKV; r -= j * I_QKV; const int kb = r / 72, nb = r % 72;
            transpose_item(a.in[12] + (size_t)j * 1024 * 2304, 2304, nb * 32, kb * 64, norm_mix + (2 * j + 1) * DM, (bf16*)(ws + WS_WQKV) + (size_t)j * 2304 * 1024, 1024, nb * 32, scr, lane); continue; } r -= 2 * I_QKV;
        if (r < 2 * I_WO) { const int j = r / I_WO; r -= j * I_WO; const int kb = r >> 5, nb = r & 31;
            transpose_item(a.in[13] + (size_t)j * 768 * 1024, 1024, nb * 32, kb * 64, nullptr, (bf16*)(ws + WS_WO) + (size_t)j * 1024 * 768, 768, nb * 32, scr, lane); continue; } r -= 2 * I_WO;
        if (r < 4 * I_GU) { const int i = r / I_GU; r -= i * I_GU; const int kb = r / 176, nb = r % 176, n0 = nb * 32;
            const float* W = ((n0 >> 7) & 1) ? a.in[16] : a.in[15]; const int src = (n0 >> 8) * 128 + (n0 & 127);
            transpose_item(W + (size_t)i * 1024 * DFF, DFF, src, kb * 64, norm_ffn + i * DM, (bf16*)(ws + WS_WGU) + (size_t)i * 5632 * 1024, 1024, n0, scr, lane); continue; } r -= 4 * I_GU;
        { const int i = r / I_DN; r -= i * I_DN; const int kb = r >> 5, nb = r & 31;
            transpose_item(a.in[17] + (size_t)i * DFF * 1024, 1024, nb * 32, kb * 64, nullptr, (bf16*)(ws + WS_WDN) + (size_t)i * 1024 * DFF, DFF, nb * 32, scr, lane); }
    }
    const float* x = a.in[0]; bf16* XB = (bf16*)(ws + WS_XB); pg8::ssq_t* ssq0 = (pg8::ssq_t*)(ws + WS_SSQ);
    for (int m = gw; m < M; m += ngw) {
        const GAS f32x4* xr = (const GAS f32x4*)(x + (size_t)m * DM) + lane; f32x4 v[4]; float s = 0.f;
#pragma unroll
        for (int j = 0; j < 4; ++j) { v[j] = xr[64 * j]; s += (v[j].x * v[j].x + v[j].y * v[j].y) + (v[j].z * v[j].z + v[j].w * v[j].w); }
        s = wave_sum(s);
        GAS unsigned long long* o8 = (GAS unsigned long long*)(XB + (size_t)m * DM) + lane;
#pragma unroll
        for (int j = 0; j < 4; ++j) o8[64 * j] = (unsigned long long)pk2(v[j].x, v[j].y) | ((unsigned long long)pk2(v[j].z, v[j].w) << 32);
        if (lane == 0) ssq0[m] = pg8::ssq_enc(s);
    }
}

__device__ __forceinline__ void conv_phase(const bf16* U, const float* wdw, const float* bdw, const float* lng, const float* lnb, bf16* C, LAS unsigned char* lds, int vcu, int G, int tid_) {
    float w0[CONVW], w1[CONVW];
    { const int c0 = 2 * tid_;
#pragma unroll
      for (int k = 0; k < CONVW; ++k) { const float2 w = *(const float2*)(wdw + k * DM + c0); w0[k] = w.x; w1[k] = w.y; } }
    constexpr int NT = M / 32; const int tpw = (NT + G - 1) / G;
    for (int ti = 0; ti < tpw; ++ti) { const int tile = vcu * tpw + ti; if (tile >= NT) break;
        int tid = tid_; asm volatile("" : "+v"(tid));
        const int c0 = 2 * tid, lane = tid & 63, wave = __builtin_amdgcn_readfirstlane(tid >> 6);
        const int m0 = tile * 32, tb = m0 & (SEQ - 1);
        const unsigned ubase = (unsigned)(m0 - 30) * (DM * 2);
#pragma unroll
        for (int it = 0; it < 16; ++it) { const int idx = tid + 512 * it;
            if (idx < 62 * 128) { const int row = idx >> 7, ch = idx & 127; v4u v = (v4u){0u, 0u, 0u, 0u};
                if (tb - 30 + row >= 0) v = *(const GAS v4u*)((const char*)U + (size_t)(ubase + (unsigned)(row * 2048 + ch * 16)));
                *(LAS v4u*)(lds + row * 2048 + ch * 16) = v; } }
        __syncthreads();
        const float2 bd = *(const float2*)(bdw + c0);
        float a0[32], a1[32];
#pragma unroll
        for (int t = 0; t < 32; ++t) { a0[t] = bd.x; a1[t] = bd.y; }
        const LAS unsigned char* xin = lds + tid * 4;
#pragma unroll
        for (int rho = 0; rho < 62; ++rho) { const unsigned xw = *(const LAS unsigned*)(xin + rho * 2048);
            const float x0 = __uint_as_float(xw << 16), x1 = __uint_as_float(xw & 0xffff0000u);
#pragma unroll
            for (int t = 0; t < 32; ++t) { if (rho - t >= 0 && rho - t <= 30) { a0[t] += w0[rho - t] * x0; a1[t] += w1[rho - t] * x1; } }
            if ((rho & 3) == 3) asm volatile("" ::: "memory"); }
        __syncthreads();
        LAS float* P = (LAS float*)lds + (tid >> 2); LAS float* stats = (LAS float*)(lds + 32768);
#pragma unroll
        for (int t = 0; t < 32; ++t) { float s1 = a0[t] + a1[t], s2 = a0[t] * a0[t] + a1[t] * a1[t];
            s1 += __shfl_xor(s1, 1); s2 += __shfl_xor(s2, 1); s1 += __shfl_xor(s1, 2); s2 += __shfl_xor(s2, 2);
            if ((tid & 3) == 0) { P[(2 * t) * 128] = s1; P[(2 * t + 1) * 128] = s2; } }
        __syncthreads();
        { const LAS float* Pr = (const LAS float*)lds + wave * 8 * 128 + lane;
#pragma unroll
          for (int j = 0; j < 8; ++j) { float s = Pr[j * 128] + Pr[j * 128 + 64]; s = wave_sum(s); if (lane == 0) stats[wave * 8 + j] = s; } }
        __syncthreads();
        const float2 g2 = *(const float2*)(lng + c0), b2 = *(const float2*)(lnb + c0);
        unsigned* crow = (unsigned*)((char*)C + (size_t)((unsigned)m0 * (DM * 2) + (unsigned)c0 * 2));
#pragma unroll
        for (int t = 0; t < 32; ++t) { const float mean = stats[2 * t] * (1.0f / DM), var = stats[2 * t + 1] * (1.0f / DM) - mean * mean; const float rstd = __builtin_amdgcn_rsqf(var + 1e-6f);
            const float y0 = (a0[t] - mean) * rstd * g2.x + b2.x, y1 = (a1[t] - mean) * rstd * g2.y + b2.y;
            const float o0 = y0 * pg8::sigmoid_f(y0), o1 = y1 * pg8::sigmoid_f(y1);
            crow[t * (DM / 2)] = pk2(o0, o1); }
        __syncthreads();
    }
}

__global__ void __launch_bounds__(NWAVES * 64, 2) trunk_fwd(Args args) {
    extern __shared__ __attribute__((aligned(16))) unsigned char lds[];
    LAS unsigned char* L = (LAS unsigned char*)lds;
    volatile LAS unsigned* MISC = (volatile LAS unsigned*)(L + MISC_OFF);
    const int tid0 = threadIdx.x, wave = __builtin_amdgcn_readfirstlane(tid0 >> 6);
    const int G = gridDim.x, bx = blockIdx.x, vcu = (G % 8 == 0) ? (bx % 8) * (G / 8) + bx / 8 : bx;
    unsigned char* ws = args.ws;
    gu32* ctl = (gu32*)(ws + WS_CTL);
    if (tid0 < 64) MISC[tid0] = 0u;
    __syncthreads();
    XcdBarrier bar = xcd_barrier_post((unsigned*)(ctl + CW_BAR), MISC + 8);
    const int lo = args.ph_lo, hi = args.ph_hi; int pid = 0;
#define PH_BEGIN if (pid >= lo && pid < hi) { int tid = tid0; asm volatile("" : "+v"(tid)); const int lane = tid & 63; (void)lane;
#define PH_END   if (pid + 1 < hi) xcd_barrier(bar); } ++pid;
    float* X = args.out;
    bf16* XB = (bf16*)(ws + WS_XB); pg8::ssq_t* SSQ = (pg8::ssq_t*)(ws + WS_SSQ);
    bf16* R0 = (bf16*)(ws + WS_R);
    const int gw = vcu * NWAVES + wave, ngw = G * NWAVES;

    PH_BEGIN prologue(args, L, gw, ngw, wave, lane); PH_END

    for (int layer = 0; layer < DEPTH; ++layer) {
        const int j = layer >> 1;
        const float* resid_in = (layer == 0) ? args.in[0] : X;
        if ((layer & 1) == 0) {
            bf16* U = R0; bf16* C = R0 + (size_t)M * DM;
            PH_BEGIN
                pg8::Gemm g{XB, (const bf16*)(ws + WS_WPW1) + (size_t)j * 2048 * 1024, M, 2048, 1024}; pg8::StaticOrder S; S.init(M, 2048, G, bx);
                pg8::EpiGate<0> E{U, DM, SSQ + (size_t)layer * M, args.in[5] + j * 2048};
                pg8::gemm_phase<pg8::EpiGate<0>, pg8::StaticOrder, true, true>(L, g, S, E);
            PH_END
            PH_BEGIN
                conv_phase(U, args.in[6] + (size_t)j * CONVW * DM, args.in[7] + j * DM, args.in[8] + j * DM, args.in[9] + j * DM, C, L, vcu, G, tid);
            PH_END
            PH_BEGIN
                pg8::Gemm g{C, (const bf16*)(ws + WS_WPW2) + (size_t)j * 1024 * 1024, M, 1024, 1024}; pg8::StaticOrder S; S.init(M, 1024, G, bx);
                pg8::EpiResid E{resid_in, X, XB, DM, args.in[11] + j * DM, SSQ + (size_t)(4 + layer) * M};
                pg8::gemm_phase<pg8::EpiResid, pg8::StaticOrder, true, true>(L, g, S, E);
            PH_END
        } else {
            bf16* Qb = R0; bf16* Kb = R0 + (size_t)M * DATT; bf16* Vb = R0 + 2 * (size_t)M * DATT; float* LSE = (float*)(ws + WS_LSE);
            PH_BEGIN
                pg8::Gemm g{XB, (const bf16*)(ws + WS_WQKV) + (size_t)j * 2304 * 1024, M, 2304, 1024}; pg8::StaticOrder S; S.init(M, 2304, G, bx);
                pg8::EpiQkv E{Qb, DATT, SSQ + (size_t)layer * M, DATT, (size_t)M * DATT, 0.125f * 1.4426950408889634f};
                pg8::gemm_phase<pg8::EpiQkv, pg8::StaticOrder, true, true>(L, g, S, E);
            PH_END
            PH_BEGIN
                const int upw = (dattn::NUNITS + G - 1) / G;
                for (int i = 0; i < upw; ++i) { const int u = vcu * upw + i; if (u >= dattn::NUNITS) break; dattn::attn_unit(u, Qb, Kb, Vb, Qb, LSE, args.in[14], (LAS char*)L); }
            PH_END
            PH_BEGIN
                dattn::scale_rows(Qb, LSE, gw, ngw, lane);
            PH_END
            PH_BEGIN
                pg8::Gemm g{Qb, (const bf16*)(ws + WS_WO) + (size_t)j * 1024 * 768, M, 1024, 768}; pg8::StaticOrder S; S.init(M, 1024, G, bx);
                pg8::EpiResid E{resid_in, X, XB, DM, nullptr, SSQ + (size_t)(4 + layer) * M};
                pg8::gemm_phase<pg8::EpiResid, pg8::StaticOrder, true, true>(L, g, S, E);
            PH_END
        }
        bf16* H = R0;
        PH_BEGIN
            pg8::Gemm g{XB, (const bf16*)(ws + WS_WGU) + (size_t)layer * 5632 * 1024, M, 5632, 1024}; pg8::StaticOrder S; S.init(M, 5632, G, bx);
            pg8::EpiGate<1> E{H, DFF, SSQ + (size_t)(4 + layer) * M, nullptr};
            pg8::gemm_phase<pg8::EpiGate<1>, pg8::StaticOrder, true, true>(L, g, S, E);
        PH_END
        PH_BEGIN
            pg8::Gemm g{H, (const bf16*)(ws + WS_WDN) + (size_t)layer * 1024 * DFF, M, 1024, DFF}; pg8::StaticOrder S; S.init(M, 1024, G, bx);
            pg8::EpiResid E{X, X, XB, DM, nullptr, SSQ + (size_t)(layer == DEPTH - 1 ? 8 : layer + 1) * M};
            pg8::gemm_phase<pg8::EpiResid, pg8::StaticOrder, true, true>(L, g, S, E);
        PH_END
    }
    PH_BEGIN
        const float* fn = args.in[3]; const pg8::ssq_t* ssq = SSQ + (size_t)8 * M;
        for (int m = gw; m < M; m += ngw) { GAS f32x4* xr = (GAS f32x4*)(X + (size_t)m * DM) + lane; const float rs = pg8::rstd_of(ssq + m);
#pragma unroll
            for (int q = 0; q < 4; ++q) { const f32x4 v = xr[64 * q]; const f32x4 gq = *((const f32x4*)fn + lane + 64 * q); xr[64 * q] = v * rs * gq; } }
    PH_END
#undef PH_BEGIN
#undef PH_END
}

constexpr int N_PHASES = 1 + 2 * 5 + 2 * 6 + 1;
#ifndef MK_PER_PHASE
#define MK_PER_PHASE 1
#endif
extern "C" void kernel_launch(void* const* d_in, const int* in_sizes, int n_in, void* d_out, int out_size, void* d_ws, size_t ws_size, hipStream_t stream) {
    static int grid = 0;
    if (grid == 0) {
        if (n_in != 18 || in_sizes[0] != M * DM || out_size != M * DM || ws_size < WS_END) { fprintf(stderr, "kernel_launch: unexpected shapes (n_in %d, in0 %d, out %d, ws %zu); nothing launched\n", n_in, n_in > 0 ? in_sizes[0] : -1, out_size, ws_size); grid = -1; return; }
        int dev = 0, cus = 0, per_cu = 0;
        if (hipGetDevice(&dev) != hipSuccess || hipDeviceGetAttribute(&cus, hipDeviceAttributeMultiprocessorCount, dev) != hipSuccess) { grid = -1; return; }
        if (hipFuncSetAttribute((const void*)trunk_fwd, hipFuncAttributeMaxDynamicSharedMemorySize, LDS_BYTES) != hipSuccess) { fprintf(stderr, "kernel_launch: hipFuncSetAttribute failed\n"); grid = -1; return; }
        if (hipOccupancyMaxActiveBlocksPerMultiprocessor(&per_cu, (const void*)trunk_fwd, NWAVES * 64, LDS_BYTES) != hipSuccess || per_cu < 1) { fprintf(stderr, "kernel_launch: occupancy query says %d blocks per CU\n", per_cu); }
        (void)hipGetLastError();
        grid = cus;
    }
    if (grid < 0) return;
    (void)hipMemsetAsync((char*)d_ws + WS_CTL, 0, CTL_ZERO_BYTES, stream);
    Args a{};
    for (int i = 0; i < 18; ++i) a.in[i] = (const float*)d_in[i];
    a.out = (float*)d_out; a.ws = (unsigned char*)d_ws;
#if MK_PER_PHASE
    for (int p = 0; p < N_PHASES; ++p) { a.ph_lo = p; a.ph_hi = p + 1; hipLaunchKernelGGL(trunk_fwd, dim3(grid), dim3(NWAVES * 64), LDS_BYTES, stream, a); }
#else
    a.ph_lo = 0; a.ph_hi = N_PHASES; hipLaunchKernelGGL(trunk_fwd, dim3(grid), dim3(NWAVES * 64), LDS_BYTES, stream, a);
#endif
}
```

```cpp
#include <hip/hip_runtime.h>
#include <cstdio>
#include <cstdint>
#include <cmath>
#ifndef PG8_WGM
#define PG8_WGM 8
#endif
namespace pg8 {
#define PG8_LAS __attribute__((address_space(3)))
typedef unsigned short bf16_t;
typedef short bf16x8 __attribute__((ext_vector_type(8)));
typedef float f32x4 __attribute__((ext_vector_type(4)));
typedef unsigned u32x4 __attribute__((ext_vector_type(4)));
constexpr int BM = 256, BK = 64, HALF = 128, HTB = HALF * BK * 2  , STAGE_BYTES = 8 * HTB, NXCD = 8, WGM = PG8_WGM;

__host__ __device__ __forceinline__ int lds_byte(int r, int c) { const int st = (r >> 4) * 2 + (c >> 5), rr = r & 15, cc = c & 31, ob = rr * 64 + cc * 2; return st * 1024 + (ob ^ (((ob >> 9) & 1) << 5)); }
__host__ __device__ __forceinline__ void stage_rc(int b, int& R, int& C) { const int st = b / 1024, sb = b % 1024, swz = sb ^ (((sb >> 9) & 1) << 5); R = (st >> 1) * 16 + swz / 64; C = (st & 1) * 32 + (swz % 64) / 2; }
__host__ __device__ __forceinline__ int perm32(int rho) { const int n = rho >> 4, i = rho & 15; return 8 * (i >> 2) + 4 * n + (i & 3); }

struct Unit { int pm, pn; };
struct Gemm { const bf16_t* A; const bf16_t* Bt; int M, N, K; bool tiledA; int lda = 0; };
__host__ __device__ __forceinline__ size_t tiled_off(int row, int col, int K) { return ((size_t)(row >> 7) * (K >> 6) + (col >> 6)) * 8192 + (size_t)((row & 127) * 64 + (col & 63)); }

struct StaticOrder {
    int nM, nN, nwg, G, c, lim;
    __host__ __device__ void init(int M, int N, int G_, int c_, bool whole_rounds_only = false) { nM = M / BM; nN = N / BM; nwg = nM * nN; G = G_; c = c_; lim = whole_rounds_only ? (nwg / G) * G : nwg; }
    __host__ __device__ bool unit_at(long L, Unit& u) const {
        int wgid = (int)L; { const int q = nwg / NXCD, r = nwg % NXCD, xcd = wgid % NXCD, off = wgid / NXCD; wgid = (xcd < r ? xcd * (q + 1) : r * (q + 1) + (xcd - r) * q) + off; }
        const int nig = WGM * nN, gid = wgid / nig, fm = gid * WGM, gsz = (nM - fm) < WGM ? (nM - fm) : WGM;
        u.pm = fm + ((wgid % nig) % gsz); u.pn = (wgid % nig) / gsz; return true;
    }
    __host__ __device__ bool next(int i, Unit& u) const {
        const long L = (long)i * G + c; if (L >= lim) return false;
        int wgid = (int)L; { const int q = nwg / NXCD, r = nwg % NXCD, xcd = wgid % NXCD, off = wgid / NXCD; wgid = (xcd < r ? xcd * (q + 1) : r * (q + 1) + (xcd - r) * q) + off; }
        const int nig = WGM * nN, gid = wgid / nig, fm = gid * WGM, gsz = (nM - fm) < WGM ? (nM - fm) : WGM;
        u.pm = fm + ((wgid % nig) % gsz); u.pn = (wgid % nig) / gsz; return true;
    }
    __device__ __forceinline__ void a_ready(const Unit&) const {}
    __device__ __forceinline__ void done(const Unit&) const {}
};

__device__ __forceinline__ unsigned cvt_pk_bf16(float lo, float hi) { unsigned r; asm volatile("v_cvt_pk_bf16_f32 %0, %1, %2" : "=v"(r) : "v"(lo), "v"(hi)); return r; }
typedef float f32x2 __attribute__((ext_vector_type(2)));
#ifndef REP_EPI_GU
#define REP_EPI_GU 1
#endif
typedef unsigned u32x2 __attribute__((ext_vector_type(2)));
#ifndef NT_STORES
#define NT_STORES 0
#endif
#ifndef WT_STORES
#define WT_STORES 0
#endif
#ifndef LAST_UNIT_WT
#define LAST_UNIT_WT 0
#endif
#ifndef QKV_NT
#define QKV_NT 0
#endif
#ifndef RESID_WT
#define RESID_WT 1
#endif
__device__ __forceinline__ void store16_resid(void* p, u32x4 v) {
#if RESID_WT
    asm volatile("global_store_dwordx4 %0, %1, off sc1\n\ts_nop 1" :: "v"(p), "v"(v) : "memory");
#else
    *(u32x4*)p = v;
#endif
}
__device__ __forceinline__ void store16_sel(void* p, u32x4 v, bool wt) {
    if (wt) asm volatile("global_store_dwordx4 %0, %1, off sc1\n\ts_nop 1" :: "v"(p), "v"(v) : "memory");
    else *(u32x4*)p = v;
}
__device__ __forceinline__ void store16_out(void* p, u32x4 v) {
#if WT_STORES
    asm volatile("global_store_dwordx4 %0, %1, off sc1\n\ts_nop 1" :: "v"(p), "v"(v) : "memory");
#elif NT_STORES
    __builtin_nontemporal_store(v, (u32x4*)p);
#else
    *(u32x4*)p = v;
#endif
}
constexpr float RMS_EPS = 1e-6f, INV_DM = 1.0f / 1024.0f, LOG2E_F = 1.4426950408889634f;
typedef unsigned long long ssq_t;
constexpr float SSQ_SCALE = 1073741824.0f, SSQ_INV = 1.0f / 1073741824.0f;
__device__ __forceinline__ ssq_t ssq_enc(float s) { return (ssq_t)(s * SSQ_SCALE); }
__device__ __forceinline__ float rstd_of(const ssq_t* p) { return __builtin_amdgcn_rsqf((float)(*p) * (SSQ_INV * INV_DM) + RMS_EPS); }
template <int NAI> __device__ __forceinline__ void load_rstd8(const ssq_t* ssq, int row0, int fr, int fq, float sc, float (&rsv)[8]) {
    const float v0 = rstd_of(ssq + row0 + fq * 16) * sc, v1 = (NAI == 2) ? rstd_of(ssq + row0 + HALF + fq * 16) * sc : 0.f;
#pragma unroll
    for (int m = 0; m < 4; ++m) { rsv[m] = __shfl(v0, fr + 16 * m); rsv[4 + m] = (NAI == 2) ? __shfl(v1, fr + 16 * m) : 0.f; }
}
template <int NAI> __device__ __forceinline__ void load_rstd8_lds(PG8_LAS const ssq_t* ls, int rloc, int fr, int fq, float sc, float (&rsv)[8]) {
    const ssq_t s0 = ls[rloc + fq * 16], s1 = (NAI == 2) ? ls[rloc + HALF + fq * 16] : 0ull;
    const float v0 = __builtin_amdgcn_rsqf((float)s0 * (SSQ_INV * INV_DM) + RMS_EPS) * sc, v1 = (NAI == 2) ? __builtin_amdgcn_rsqf((float)s1 * (SSQ_INV * INV_DM) + RMS_EPS) * sc : 0.f;
#pragma unroll
    for (int m = 0; m < 4; ++m) { rsv[m] = __shfl(v0, fr + 16 * m); rsv[4 + m] = (NAI == 2) ? __shfl(v1, fr + 16 * m) : 0.f; }
}
#ifndef SSQ_PREFETCH
#define SSQ_PREFETCH 0
#endif
__device__ __forceinline__ float sigmoid_f(float x) { return __builtin_amdgcn_rcpf(1.0f + __builtin_amdgcn_exp2f(-LOG2E_F * x)); }

template <int MODE> struct EpiGate {
    static constexpr bool PERM = true, AFTER_DRAIN = false, RESID_PF = false, SSQ_PF = (SSQ_PREFETCH != 0), LAST_WT = (LAST_UNIT_WT != 0); static constexpr int REPS = (MODE == 1) ? REP_EPI_GU : 1;
    bf16_t* O; int ldc; const ssq_t* ssq; const float* bias; bool tiledO; bool wt = false; int probe = 0;
    __device__ __forceinline__ void operator()(const f32x4 (&acc)[2][2][4][2], const Unit& u, int wr, int wc, int fr, int fq) const { run<2>(acc, u, wr, wc, fr, fq, 0); }
    __device__ __forceinline__ void with_lds_ssq(const f32x4 (&acc)[2][2][4][2], const Unit& u, int wr, int wc, int fr, int fq, PG8_LAS const ssq_t* ls) const { run<2>(acc, u, wr, wc, fr, fq, 0, ls); }
    template <int NAI> __device__ __forceinline__ void run(const f32x4 (&acc)[2][2][4][2], const Unit& u, int wr, int wc, int fr, int fq, int rshift, PG8_LAS const ssq_t* ls = nullptr) const {
        if (probe == 1) return;
        const int row0 = u.pm * BM + rshift + wr * 64 + fr, col0 = u.pn * HALF + wc * 32 + 8 * fq;
        f32x4 b0[2], b1[2];
#pragma unroll
        for (int n = 0; n < 2; ++n) {
            if (MODE == 0) { b0[n] = *(const f32x4*)(bias + col0 + 4 * n); b1[n] = *(const f32x4*)(bias + 1024 + col0 + 4 * n); }
            else { b0[n] = (f32x4){0.f, 0.f, 0.f, 0.f}; b1[n] = b0[n]; } }
        float rsv[8]; if (ls) load_rstd8_lds<NAI>(ls, rshift + wr * 64 + fr, fr, fq, 1.0f, rsv); else load_rstd8<NAI>(ssq, row0, fr, fq, 1.0f, rsv);
#pragma unroll
        for (int ai = 0; ai < NAI; ++ai)
#pragma unroll
            for (int m = 0; m < 4; ++m) { const int row = row0 + ai * HALF + m * 16;
                const float rs = rsv[ai * 4 + m];
                u32x4 w; unsigned wv[4];
#pragma unroll
                for (int n = 0; n < 2; ++n) { f32x4 o, t, r;
                    if (MODE == 0) { const f32x4 p = acc[ai][0][m][n] * rs + b0[n]; t = (acc[ai][1][m][n] * rs + b1[n]) * (-LOG2E_F);
#pragma unroll
                        for (int i = 0; i < 4; ++i) t[i] = __builtin_amdgcn_exp2f(t[i]);
                        t = t + 1.0f;
#pragma unroll
                        for (int i = 0; i < 4; ++i) r[i] = __builtin_amdgcn_rcpf(t[i]);
                        o = p * r; }
                    else { t = acc[ai][0][m][n] * (rs * -LOG2E_F);
#pragma unroll
                        for (int i = 0; i < 4; ++i) t[i] = __builtin_amdgcn_exp2f(t[i]);
                        t = t + 1.0f;
#pragma unroll
                        for (int i = 0; i < 4; ++i) r[i] = __builtin_amdgcn_rcpf(t[i]);
                        o = (acc[ai][0][m][n] * acc[ai][1][m][n]) * (rs * rs) * r; }
                    wv[2 * n] = cvt_pk_bf16(o[0], o[1]); wv[2 * n + 1] = cvt_pk_bf16(o[2], o[3]); }
                w.x = wv[0]; w.y = wv[1]; w.z = wv[2]; w.w = wv[3];
                if (probe == 2) asm volatile("" :: "v"(w)); else store16_sel(tiledO ? O + tiled_off(row, col0, ldc) : O + (size_t)row * ldc + col0, w, wt); }
    }
};
struct EpiQkv {
    static constexpr bool PERM = true, AFTER_DRAIN = false, RESID_PF = false, SSQ_PF = (SSQ_PREFETCH != 0), LAST_WT = (LAST_UNIT_WT != 0); static constexpr int REPS = 1;
    bf16_t* O; int ldc; const ssq_t* ssq; int split_cols; size_t split_stride; float scale0; bool wt = false;
    __device__ __forceinline__ void operator()(const f32x4 (&acc)[2][2][4][2], const Unit& u, int wr, int wc, int fr, int fq) const { run<2>(acc, u, wr, wc, fr, fq, 0); }
    __device__ __forceinline__ void with_lds_ssq(const f32x4 (&acc)[2][2][4][2], const Unit& u, int wr, int wc, int fr, int fq, PG8_LAS const ssq_t* ls) const { run<2>(acc, u, wr, wc, fr, fq, 0, ls); }
    template <int NAI> __device__ __forceinline__ void run(const f32x4 (&acc)[2][2][4][2], const Unit& u, int wr, int wc, int fr, int fq, int rshift, PG8_LAS const ssq_t* ls = nullptr) const {
        const int row0 = u.pm * BM + rshift + wr * 64 + fr; int colt = u.pn * BM; bf16_t* base = O;
        float sc = 1.f; { const int t = colt / split_cols; base += (size_t)t * split_stride; colt -= t * split_cols; if (t == 0) sc = scale0; }
        const int col0 = colt + wc * 32 + 8 * fq;
        float rsv[8]; if (ls) load_rstd8_lds<NAI>(ls, rshift + wr * 64 + fr, fr, fq, sc, rsv); else load_rstd8<NAI>(ssq, row0, fr, fq, sc, rsv);
#pragma unroll
        for (int ai = 0; ai < NAI; ++ai)
#pragma unroll
            for (int m = 0; m < 4; ++m) { const int row = row0 + ai * HALF + m * 16;
                const float rs = rsv[ai * 4 + m];
                bf16_t* rowp = base + (size_t)row * ldc + col0;
#pragma unroll
                for (int bj = 0; bj < 2; ++bj) { const f32x4 v0 = acc[ai][bj][m][0] * rs, v1 = acc[ai][bj][m][1] * rs;
                    u32x4 w; w.x = cvt_pk_bf16(v0[0], v0[1]); w.y = cvt_pk_bf16(v0[2], v0[3]); w.z = cvt_pk_bf16(v1[0], v1[1]); w.w = cvt_pk_bf16(v1[2], v1[3]);
#if QKV_NT
                    __builtin_nontemporal_store(w, (u32x4*)(rowp + bj * HALF)); } }
#else
                    store16_sel(rowp + bj * HALF, w, wt); } }
#endif
    }
};
#ifndef RESID_PREFETCH
#define RESID_PREFETCH 1
#endif
template <bool BASE_F32, bool HAS_BIAS> struct EpiResid {
    static constexpr bool PERM = true, AFTER_DRAIN = false, RESID_PF = !BASE_F32 && (RESID_PREFETCH != 0), SSQ_PF = false, LAST_WT = false; static constexpr int REPS = 1;
    static constexpr int NB = BASE_F32 ? 2 : (HAS_BIAS ? 4 : 8);
    const float* basef; const bf16_t* xin; bf16_t* xb; int ldc; const float* bias; ssq_t* ssq_out;
    __device__ __forceinline__ void operator()(const f32x4 (&acc)[2][2][4][2], const Unit& u, int wr, int wc, int fr, int fq) const {
        const int row0 = u.pm * BM + wr * 64 + fr, col0 = u.pn * BM + wc * 32 + 8 * fq;
        f32x4 bv[2][2];
#pragma unroll
        for (int bj = 0; bj < 2; ++bj)
#pragma unroll
            for (int n = 0; n < 2; ++n) bv[bj][n] = HAS_BIAS ? *(const f32x4*)(bias + col0 + bj * HALF + n * 4) : (f32x4){0.f, 0.f, 0.f, 0.f};
        unsigned eoff0 = (unsigned)row0 * (unsigned)ldc + (unsigned)col0;
#pragma unroll
        for (int qb = 0; qb < 8; qb += NB) { asm volatile("" : "+v"(eoff0));
            u32x4 raw[NB][2]; f32x4 rawf[NB][2][2];
#pragma unroll
            for (int k = 0; k < NB; ++k) { const int q = qb + k; const unsigned eo = eoff0 + (unsigned)((q >> 2) * HALF + (q & 3) * 16) * (unsigned)ldc;
#pragma unroll
                for (int bj = 0; bj < 2; ++bj) {
                    if (BASE_F32) { rawf[k][bj][0] = *(const f32x4*)(basef + eo + bj * HALF); rawf[k][bj][1] = *(const f32x4*)(basef + eo + bj * HALF + 4); }
                    else raw[k][bj] = *(const u32x4*)(xin + eo + bj * HALF); } }
#pragma unroll
            for (int k = 0; k < NB; ++k) { const int q = qb + k, ai = q >> 2, m = q & 3; const unsigned eo = eoff0 + (unsigned)(ai * HALF + m * 16) * (unsigned)ldc;
                const int row = row0 + ai * HALF + m * 16; float s = 0.f;
#pragma unroll
                for (int bj = 0; bj < 2; ++bj) { f32x4 b0, b1;
                    if (BASE_F32) { b0 = rawf[k][bj][0]; b1 = rawf[k][bj][1]; }
                    else { const u32x4 w = raw[k][bj];
                        b0 = (f32x4){__uint_as_float(w.x << 16), __uint_as_float(w.x & 0xffff0000u), __uint_as_float(w.y << 16), __uint_as_float(w.y & 0xffff0000u)};
                        b1 = (f32x4){__uint_as_float(w.z << 16), __uint_as_float(w.z & 0xffff0000u), __uint_as_float(w.w << 16), __uint_as_float(w.w & 0xffff0000u)}; }
                    const f32x4 o0 = b0 + acc[ai][bj][m][0] + bv[bj][0], o1 = b1 + acc[ai][bj][m][1] + bv[bj][1];
                    u32x4 w; w.x = cvt_pk_bf16(o0[0], o0[1]); w.y = cvt_pk_bf16(o0[2], o0[3]); w.z = cvt_pk_bf16(o1[0], o1[1]); w.w = cvt_pk_bf16(o1[2], o1[3]);
                    store16_resid(xb + eo + bj * HALF, w);
                    s += (o0[0] * o0[0] + o0[1] * o0[1]) + (o0[2] * o0[2] + o0[3] * o0[3]) + (o1[0] * o1[0] + o1[1] * o1[1]) + (o1[2] * o1[2] + o1[3] * o1[3]); }
                s += __shfl_xor(s, 16); s += __shfl_xor(s, 32);
                if (fq == 0) atomicAdd(ssq_out + row, ssq_enc(s)); }
            asm volatile("" ::: "memory"); }
    }
    __device__ __forceinline__ unsigned pf_voff(const Unit& u, int wr, int wc, int fr, int fq) const {
        return ((unsigned)(u.pm * BM + wr * 64 + fr) * (unsigned)ldc + (unsigned)(u.pn * BM + wc * 32 + 8 * fq)) * 2u; }
    __device__ __forceinline__ const char* pf_base(int j) const { return (const char*)xin + (size_t)((j >> 2) * HALF + (j & 3) * 16) * (size_t)ldc * 2; }
    __device__ __forceinline__ void pf(const f32x4 (&acc)[2][2][4][2], const Unit& u, int wr, int wc, int fr, int fq, PG8_LAS unsigned char* lds, int wid, int lane) const {
        const int row0 = u.pm * BM + wr * 64 + fr, col0 = u.pn * BM + wc * 32 + 8 * fq;
        f32x4 bv[2][2];
#pragma unroll
        for (int bj = 0; bj < 2; ++bj)
#pragma unroll
            for (int n = 0; n < 2; ++n) bv[bj][n] = HAS_BIAS ? *(const f32x4*)(bias + col0 + bj * HALF + n * 4) : (f32x4){0.f, 0.f, 0.f, 0.f};
        const unsigned eoff0 = (unsigned)row0 * (unsigned)ldc + (unsigned)col0;
        u32x4 r7[2];
#pragma unroll
        for (int bj = 0; bj < 2; ++bj) r7[bj] = *(const u32x4*)(xin + eoff0 + (unsigned)(HALF + 48) * (unsigned)ldc + bj * HALF);
        const unsigned lo = (unsigned)wid * 1024u + (unsigned)lane * 16u;
#pragma unroll
        for (int qb = 0; qb < 8; qb += 4) {
            u32x4 raw[4][2];
#pragma unroll
            for (int k = 0; k < 4; ++k) { const int q = qb + k;
                const int slot = q == 0 ? 4 : q == 1 ? 5 : q == 2 ? 0 : q == 3 ? 1 : q == 4 ? 6 : q == 5 ? 7 : 2;
#pragma unroll
                for (int bj = 0; bj < 2; ++bj) { if (q < 7) raw[k][bj] = *(const PG8_LAS u32x4*)(lds + slot * HTB + bj * 8192 + lo); else raw[k][bj] = r7[bj]; } }
#pragma unroll
            for (int k = 0; k < 4; ++k) { const int q = qb + k, ai = q >> 2, m = q & 3; const unsigned eo = eoff0 + (unsigned)(ai * HALF + m * 16) * (unsigned)ldc;
                const int row = row0 + ai * HALF + m * 16; float s = 0.f;
#pragma unroll
                for (int bj = 0; bj < 2; ++bj) { const u32x4 w0 = raw[k][bj];
                    const f32x4 b0 = (f32x4){__uint_as_float(w0.x << 16), __uint_as_float(w0.x & 0xffff0000u), __uint_as_float(w0.y << 16), __uint_as_float(w0.y & 0xffff0000u)};
                    const f32x4 b1 = (f32x4){__uint_as_float(w0.z << 16), __uint_as_float(w0.z & 0xffff0000u), __uint_as_float(w0.w << 16), __uint_as_float(w0.w & 0xffff0000u)};
                    const f32x4 o0 = b0 + acc[ai][bj][m][0] + bv[bj][0], o1 = b1 + acc[ai][bj][m][1] + bv[bj][1];
                    u32x4 w; w.x = cvt_pk_bf16(o0[0], o0[1]); w.y = cvt_pk_bf16(o0[2], o0[3]); w.z = cvt_pk_bf16(o1[0], o1[1]); w.w = cvt_pk_bf16(o1[2], o1[3]);
                    store16_resid(xb + eo + bj * HALF, w);
                    s += (o0[0] * o0[0] + o0[1] * o0[1]) + (o0[2] * o0[2] + o0[3] * o0[3]) + (o1[0] * o1[0] + o1[1] * o1[1]) + (o1[2] * o1[2] + o1[3] * o1[3]); }
                s += __shfl_xor(s, 16); s += __shfl_xor(s, 32);
                if (fq == 0) atomicAdd(ssq_out + row, ssq_enc(s)); } }
    }
};

struct EpiFinal {
    static constexpr bool PERM = true, AFTER_DRAIN = false, RESID_PF = false, SSQ_PF = false, LAST_WT = false; static constexpr int REPS = 1;
    const bf16_t* xin; float* out; int ldc; const float* gain; ssq_t* ssq; unsigned* cnt; PG8_LAS unsigned* flag; unsigned want;
    __device__ __forceinline__ void operator()(const f32x4 (&acc_)[2][2][4][2], const Unit& u, int wr, int wc, int fr, int fq) const {
        f32x4 (&acc)[2][2][4][2] = const_cast<f32x4 (&)[2][2][4][2]>(acc_);
        const int row0 = u.pm * BM + wr * 64 + fr, col0 = u.pn * BM + wc * 32 + 8 * fq, lane = fr + 16 * fq, wid = wr * 4 + wc;
        unsigned eoff0 = (unsigned)row0 * (unsigned)ldc + (unsigned)col0;
#pragma unroll
        for (int qb = 0; qb < 8; qb += 4) { asm volatile("" : "+v"(eoff0));
            u32x4 raw[4][2];
#pragma unroll
            for (int k = 0; k < 4; ++k) { const int q = qb + k; const unsigned eo = eoff0 + (unsigned)((q >> 2) * HALF + (q & 3) * 16) * (unsigned)ldc;
#pragma unroll
                for (int bj = 0; bj < 2; ++bj) raw[k][bj] = *(const u32x4*)(xin + eo + bj * HALF); }
#pragma unroll
            for (int k = 0; k < 4; ++k) { const int q = qb + k, ai = q >> 2, m = q & 3; const int row = row0 + ai * HALF + m * 16; float s = 0.f;
#pragma unroll
                for (int bj = 0; bj < 2; ++bj) { const u32x4 w = raw[k][bj];
                    const f32x4 b0 = (f32x4){__uint_as_float(w.x << 16), __uint_as_float(w.x & 0xffff0000u), __uint_as_float(w.y << 16), __uint_as_float(w.y & 0xffff0000u)};
                    const f32x4 b1 = (f32x4){__uint_as_float(w.z << 16), __uint_as_float(w.z & 0xffff0000u), __uint_as_float(w.w << 16), __uint_as_float(w.w & 0xffff0000u)};
                    const f32x4 o0 = b0 + acc[ai][bj][m][0], o1 = b1 + acc[ai][bj][m][1]; acc[ai][bj][m][0] = o0; acc[ai][bj][m][1] = o1;
                    s += (o0[0] * o0[0] + o0[1] * o0[1]) + (o0[2] * o0[2] + o0[3] * o0[3]) + (o1[0] * o1[0] + o1[1] * o1[1]) + (o1[2] * o1[2] + o1[3] * o1[3]); }
                s += __shfl_xor(s, 16); s += __shfl_xor(s, 32);
                if (fq == 0) atomicAdd(ssq + row, ssq_enc(s)); }
            asm volatile("" ::: "memory"); }
        asm volatile("s_waitcnt vmcnt(0)" ::: "memory");
        if (lane == 0) __hip_atomic_fetch_add(cnt + 64 * u.pm, 1u, __ATOMIC_RELAXED, __HIP_MEMORY_SCOPE_AGENT);
        if (wid == 0) {
            const unsigned long long t0 = __builtin_amdgcn_s_memrealtime();
            for (;;) {
                if ((unsigned)__builtin_amdgcn_readfirstlane(__hip_atomic_load(cnt + 64 * u.pm, __ATOMIC_RELAXED, __HIP_MEMORY_SCOPE_AGENT)) >= want) break;
                if (__builtin_amdgcn_s_memrealtime() - t0 > 2000000ull) break;
                __builtin_amdgcn_s_sleep(2); }
            __builtin_amdgcn_fence(__ATOMIC_ACQUIRE, "agent");
        }
        asm volatile("s_waitcnt vmcnt(0) lgkmcnt(0)" ::: "memory"); __builtin_amdgcn_s_barrier(); asm volatile("" ::: "memory");
        float rsv[8];
        { const ssq_t t0 = __hip_atomic_load(ssq + row0 + fq * 16, __ATOMIC_RELAXED, __HIP_MEMORY_SCOPE_AGENT), t1 = __hip_atomic_load(ssq + row0 + HALF + fq * 16, __ATOMIC_RELAXED, __HIP_MEMORY_SCOPE_AGENT);
          const float v0 = __builtin_amdgcn_rsqf((float)t0 * (SSQ_INV * INV_DM) + RMS_EPS), v1 = __builtin_amdgcn_rsqf((float)t1 * (SSQ_INV * INV_DM) + RMS_EPS);
#pragma unroll
          for (int m = 0; m < 4; ++m) { rsv[m] = __shfl(v0, fr + 16 * m); rsv[4 + m] = __shfl(v1, fr + 16 * m); } }
        f32x4 gv[2][2];
#pragma unroll
        for (int bj = 0; bj < 2; ++bj)
#pragma unroll
            for (int n = 0; n < 2; ++n) gv[bj][n] = *(const f32x4*)(gain + col0 + bj * HALF + n * 4);
#pragma unroll
        for (int ai = 0; ai < 2; ++ai)
#pragma unroll
            for (int m = 0; m < 4; ++m) { const float rs = rsv[ai * 4 + m]; float* orow = out + (size_t)(row0 + ai * HALF + m * 16) * ldc + col0;
#pragma unroll
                for (int bj = 0; bj < 2; ++bj)
#pragma unroll
                    for (int n = 0; n < 2; ++n) __builtin_nontemporal_store(acc[ai][bj][m][n] * rs * gv[bj][n], (f32x4*)(orow + bj * HALF + n * 4)); }
    }
};
#ifndef STATIC_PRIO
#define STATIC_PRIO 0
#endif
#ifndef TILED_A
#define TILED_A false
#endif
#ifndef TILED_B
#define TILED_B true
#endif
template <class Epi, class Sched, bool ALIGN_EPI = false, bool SP2 = false>
__device__ __forceinline__ void gemm_phase(PG8_LAS unsigned char* lds, const Gemm g, const Sched& S, const Epi& E) {
    int tid = threadIdx.x; asm volatile("" : "+v"(tid));
    const int wid = __builtin_amdgcn_readfirstlane(tid >> 6), lane = tid & 63, wr = wid >> 2, wc = wid & 3, fr = lane & 15, fq = lane >> 4;
    const int K = g.K, nt = K / BK, LDA = g.lda ? g.lda : K;
    unsigned voffA[2], voffB[2];
#pragma unroll
    for (int i = 0; i < 2; ++i) { int R, C; stage_rc(tid * 16 + i * 8192, R, C); const int Rb = Epi::PERM ? ((R & ~31) + perm32(R & 31)) : R;
        voffA[i] = g.tiledA ? (unsigned)(R * BK + C) * 2u : (unsigned)(R * LDA + C) * 2u; voffB[i] = TILED_B ? (unsigned)(Rb * BK + C) * 2u : (unsigned)(Rb * K + C) * 2u; }
    const size_t kstep = (size_t)(BK * 2);
    const size_t hstep = (size_t)HALF * K * 2;
    const size_t tstep = 2 * hstep;
    const size_t hstepAr = (size_t)HALF * LDA * 2, tstepA = g.tiledA ? tstep : 2 * hstepAr;
    const size_t kstepT = (size_t)HTB, hstepT = (size_t)nt * HTB;
    const size_t kstepA = g.tiledA ? kstepT : kstep, hstepA = g.tiledA ? hstepT : hstepAr, kstepB = TILED_B ? kstepT : kstep, hstepB = TILED_B ? hstepT : hstep;
    const unsigned ldsw = (unsigned)wid * 1024u;
    const int aoff = lds_byte(wr * 64 + fr, fq * 8), boff = lds_byte(wc * 32 + fr, fq * 8);
#define PG8_SA(b, h) (((b) * 2 + (h)) * HTB)
#define PG8_SB(b, h) ((4 + (b) * 2 + (h)) * HTB)
#define PG8_STAGE(bufoff, gbase, voff) do { _Pragma("unroll") for (int _i = 0; _i < 2; ++_i) \
        __builtin_amdgcn_global_load_lds((const unsigned*)((const char*)(gbase) + (voff)[_i]), (PG8_LAS unsigned*)(lds + (bufoff) + ldsw + _i * 8192), 16, 0, 0); } while (0)
#define PG8_SSQ_DMA(slot_, pm_) do { if (wid < 2) __builtin_amdgcn_global_load_lds((const unsigned*)((const char*)(E.ssq + (size_t)(pm_) * BM) + wid * 1024 + lane * 16), (PG8_LAS unsigned*)(lds + STAGE_BYTES + (slot_) * 2048 + wid * 1024), 16, 0, 0); } while (0)
#define PG8_LDA(dst, b, h) do { _Pragma("unroll") for (int m = 0; m < 4; ++m) _Pragma("unroll") for (int k = 0; k < 2; ++k) dst[m][k] = *(const PG8_LAS bf16x8*)(lds + PG8_SA(b, h) + aoff + m * 2048 + k * 1024); } while (0)
#define PG8_LDB(dst, b, h) do { _Pragma("unroll") for (int n = 0; n < 2; ++n) _Pragma("unroll") for (int k = 0; k < 2; ++k) dst[n][k] = *(const PG8_LAS bf16x8*)(lds + PG8_SB(b, h) + boff + n * 2048 + k * 1024); } while (0)
#define PG8_MMA(ai, bj, At, Bt) do { if (!STATIC_PRIO) __builtin_amdgcn_s_setprio(1); _Pragma("unroll") for (int m = 0; m < 4; ++m) _Pragma("unroll") for (int n = 0; n < 2; ++n) _Pragma("unroll") for (int k = 0; k < 2; ++k) \
        acc[ai][bj][m][n] = __builtin_amdgcn_mfma_f32_16x16x32_bf16(Bt[n][k], At[m][k], acc[ai][bj][m][n], 0, 0, 0); if (!STATIC_PRIO) __builtin_amdgcn_s_setprio(0); } while (0)
#define PG8_WAIT_V(n) asm volatile("s_waitcnt vmcnt(" #n ")" ::: "memory")
#define PG8_WAIT_L(n) asm volatile("s_waitcnt lgkmcnt(" #n ")" ::: "memory")
#define PG8_BAR __builtin_amdgcn_s_barrier()
#define PG8_SCHED __builtin_amdgcn_sched_barrier(0)
    if (STATIC_PRIO) { if (wid >= 4) __builtin_amdgcn_s_setprio(1); }
    Unit cur, nxt; int ui = 0;
    if (!S.next(0, cur)) return;
    f32x4 acc[2][2][4][2];
#pragma unroll
    for (int a = 0; a < 2; ++a)
#pragma unroll
        for (int b = 0; b < 2; ++b)
#pragma unroll
            for (int m = 0; m < 4; ++m)
#pragma unroll
                for (int n = 0; n < 2; ++n) acc[a][b][m][n] = (f32x4){0.f, 0.f, 0.f, 0.f};
    bf16x8 At[4][2], B0[2][2], B1[2][2];
    const char* cA = (const char*)g.A + (size_t)cur.pm * tstepA; const char* cB = (const char*)g.Bt + (size_t)cur.pn * tstep;
    S.a_ready(cur);
    if constexpr (Epi::SSQ_PF) PG8_SSQ_DMA(0, cur.pm);
    if constexpr (SP2) {
        PG8_STAGE(PG8_SB(0, 0), cB, voffB); PG8_STAGE(PG8_SB(0, 1), cB + hstepB, voffB); PG8_STAGE(PG8_SA(0, 0), cA, voffA); PG8_STAGE(PG8_SA(0, 1), cA + hstepA, voffA);
        if (wr == 1) PG8_BAR;
        PG8_WAIT_V(2); PG8_BAR;
        PG8_STAGE(PG8_SB(1, 0), cB + kstepB, voffB); PG8_STAGE(PG8_SA(1, 0), cA + kstepA, voffA); PG8_STAGE(PG8_SB(1, 1), cB + hstepB + kstepB, voffB);
        PG8_WAIT_V(6); PG8_BAR;
    } else {
        PG8_STAGE(PG8_SB(0, 0), cB, voffB); PG8_STAGE(PG8_SA(0, 0), cA, voffA); PG8_STAGE(PG8_SB(0, 1), cB + hstepB, voffB); PG8_STAGE(PG8_SA(0, 1), cA + hstepA, voffA);
        if (wr == 1) PG8_BAR;
        PG8_WAIT_V(4); PG8_BAR;
        PG8_STAGE(PG8_SB(1, 0), cB + kstepB, voffB); PG8_STAGE(PG8_SA(1, 0), cA + kstepA, voffA); PG8_STAGE(PG8_SB(1, 1), cB + hstepB + kstepB, voffB);
        PG8_WAIT_V(6); PG8_BAR;
    }
    for (;;) {
        const bool has_next = S.next(ui + 1, nxt);
        const char* nA = has_next ? (const char*)g.A + (size_t)nxt.pm * tstepA : cA; const char* nB = has_next ? (const char*)g.Bt + (size_t)nxt.pn * tstep : cB;
        for (int t = 0; t < nt; t += 2) {
            const bool last = (t == nt - 2);
            const char* a1 = cA + (size_t)(t + 1) * kstepA;
            const char* a2 = last ? nA : cA + (size_t)(t + 2) * kstepA; const char* b2 = last ? nB : cB + (size_t)(t + 2) * kstepB;
            const char* a3 = a2 + kstepA; const char* b3 = b2 + kstepB;
            if (last && has_next) { S.a_ready(nxt); if constexpr (Epi::SSQ_PF) PG8_SSQ_DMA((ui + 1) & 1, nxt.pm); }
            unsigned wB[2] = {voffB[0], voffB[1]}, wA[2] = {voffA[0], voffA[1]};
            const char *s0 = b2, *s1 = b2 + hstepB, *s2 = a2, *s3 = a2 + hstepA, *s4 = b3, *s5 = b3 + hstepB, *s6 = a3;
            if constexpr (SP2 && Epi::RESID_PF) { if (last && !has_next) {
                int t2 = threadIdx.x; asm volatile("" : "+v"(t2));
                const unsigned v0 = E.pf_voff(cur, wr, wc, t2 & 15, (t2 & 63) >> 4), v1 = v0 + (unsigned)(HALF * 2);
                wB[0] = v0; wB[1] = v1; wA[0] = v0; wA[1] = v1;
                s0 = E.pf_base(0); s1 = E.pf_base(1); s2 = E.pf_base(2); s3 = E.pf_base(3); s4 = E.pf_base(4); s5 = E.pf_base(5); s6 = E.pf_base(6); } }
            if constexpr (SP2) {
            PG8_LDB(B0, 0, 0); PG8_LDB(B1, 0, 1); PG8_SCHED; PG8_LDA(At, 0, 0); PG8_STAGE(PG8_SA(1, 1), a1 + hstepA, voffA);
            PG8_WAIT_V(8); PG8_WAIT_L(0); PG8_BAR; PG8_MMA(0, 0, At, B0); PG8_MMA(0, 1, At, B1); PG8_BAR; PG8_SCHED;
            PG8_LDA(At, 0, 1); PG8_STAGE(PG8_SB(0, 0), s0, wB); PG8_STAGE(PG8_SB(0, 1), s1, wB); PG8_STAGE(PG8_SA(0, 0), s2, wA);
            PG8_WAIT_V(8); PG8_WAIT_L(0); PG8_BAR; PG8_MMA(1, 0, At, B0); PG8_MMA(1, 1, At, B1); PG8_BAR; PG8_SCHED;
            PG8_LDB(B0, 1, 0); PG8_LDB(B1, 1, 1); PG8_SCHED; PG8_LDA(At, 1, 0); PG8_STAGE(PG8_SA(0, 1), s3, wA);
            PG8_WAIT_V(8); PG8_WAIT_L(0); PG8_BAR; PG8_MMA(0, 0, At, B0); PG8_MMA(0, 1, At, B1); PG8_BAR; PG8_SCHED;
            PG8_LDA(At, 1, 1); PG8_STAGE(PG8_SB(1, 0), s4, wB); PG8_STAGE(PG8_SB(1, 1), s5, wB); PG8_STAGE(PG8_SA(1, 0), s6, wA);
            PG8_WAIT_V(8); PG8_WAIT_L(0); PG8_BAR; PG8_MMA(1, 0, At, B0); PG8_MMA(1, 1, At, B1); PG8_BAR; PG8_SCHED;
            } else {
            PG8_LDB(B0, 0, 0); PG8_SCHED; PG8_LDA(At, 0, 0); PG8_STAGE(PG8_SA(1, 1), a1 + hstepA, voffA);
            PG8_WAIT_L(8); PG8_BAR; PG8_WAIT_L(0); PG8_MMA(0, 0, At, B0); PG8_BAR; PG8_SCHED;
            PG8_LDB(B1, 0, 1); PG8_STAGE(PG8_SB(0, 0), b2, voffB);
            PG8_BAR; PG8_WAIT_L(0); PG8_MMA(0, 1, At, B1); PG8_BAR;
            PG8_LDA(At, 0, 1); PG8_STAGE(PG8_SA(0, 0), a2, voffA);
            PG8_BAR; PG8_WAIT_L(0); PG8_MMA(1, 0, At, B0); PG8_BAR; PG8_SCHED;
            PG8_STAGE(PG8_SB(0, 1), b2 + hstepB, voffB);
            PG8_WAIT_V(6); PG8_BAR; PG8_MMA(1, 1, At, B1); PG8_BAR;
            PG8_LDB(B0, 1, 0); PG8_SCHED; PG8_LDA(At, 1, 0); PG8_STAGE(PG8_SA(0, 1), a2 + hstepA, voffA);
            PG8_WAIT_L(8); PG8_BAR; PG8_WAIT_L(0); PG8_MMA(0, 0, At, B0); PG8_BAR; PG8_SCHED;
            PG8_LDB(B1, 1, 1); PG8_STAGE(PG8_SB(1, 0), b3, voffB);
            PG8_BAR; PG8_WAIT_L(0); PG8_MMA(0, 1, At, B1); PG8_BAR;
            PG8_LDA(At, 1, 1); PG8_STAGE(PG8_SA(1, 0), a3, voffA);
            PG8_BAR; PG8_WAIT_L(0); PG8_MMA(1, 0, At, B0); PG8_BAR; PG8_SCHED;
            PG8_STAGE(PG8_SB(1, 1), b3 + hstepB, voffB);
            PG8_WAIT_V(6); PG8_BAR; PG8_MMA(1, 1, At, B1); PG8_BAR;
            }
        }
        if constexpr (ALIGN_EPI) { if (wr == 0) PG8_BAR; }
        if constexpr (SP2 && Epi::RESID_PF) { if (!has_next) { PG8_WAIT_V(0); E.pf(acc, cur, wr, wc, fr, fq, lds, wid, lane); } else E(acc, cur, wr, wc, fr, fq); S.done(cur); }
        else if constexpr (Epi::SSQ_PF) { for (int re_ = 0; re_ < Epi::REPS; ++re_) { E.with_lds_ssq(acc, cur, wr, wc, fr, fq, (PG8_LAS const ssq_t*)(lds + STAGE_BYTES + (ui & 1) * 2048)); asm volatile("" ::: "memory"); } S.done(cur); }
        else if constexpr (Epi::LAST_WT) { Epi E2 = E; E2.wt = !has_next; for (int re_ = 0; re_ < Epi::REPS; ++re_) { E2(acc, cur, wr, wc, fr, fq); asm volatile("" ::: "memory"); } S.done(cur); }
        else if constexpr (!Epi::AFTER_DRAIN) { for (int re_ = 0; re_ < Epi::REPS; ++re_) { E(acc, cur, wr, wc, fr, fq); asm volatile("" ::: "memory"); } S.done(cur);
#ifdef EPI_DRAIN_PROBE
            PG8_WAIT_V(0);
#endif
        }
        if (!has_next) break;
#pragma unroll
        for (int a = 0; a < 2; ++a)
#pragma unroll
            for (int b = 0; b < 2; ++b)
#pragma unroll
                for (int m = 0; m < 4; ++m)
#pragma unroll
                    for (int n = 0; n < 2; ++n) acc[a][b][m][n] = (f32x4){0.f, 0.f, 0.f, 0.f};
        cur = nxt; cA = nA; cB = nB; ++ui;
        if constexpr (ALIGN_EPI) { if (wr == 1) PG8_BAR; }
    }
    if (STATIC_PRIO) __builtin_amdgcn_s_setprio(0);
    PG8_WAIT_V(0);
    if constexpr (!ALIGN_EPI) { if (wr == 0) PG8_BAR; }
    PG8_BAR;
    if constexpr (Epi::AFTER_DRAIN) { E.fused(acc, cur, wr, wc, fr, fq, lds, wid, lane); S.done(cur); }
#undef PG8_SA
#undef PG8_SB
#undef PG8_STAGE
#undef PG8_SSQ_DMA
#undef PG8_LDA
#undef PG8_LDB
#undef PG8_MMA
#undef PG8_WAIT_V
#undef PG8_WAIT_L
#undef PG8_BAR
#undef PG8_SCHED
}
constexpr int HALF_RING_BYTES = 3 * 3 * HTB;
template <class Epi>
__device__ __forceinline__ void gemm_half_phase(PG8_LAS unsigned char* lds, const Gemm g, const StaticOrder& S, const Epi& E) {
    int tid = threadIdx.x; asm volatile("" : "+v"(tid));
    const int wid = __builtin_amdgcn_readfirstlane(tid >> 6), lane = tid & 63, wr = wid >> 2, wc = wid & 3, fr = lane & 15, fq = lane >> 4;
    const int K = g.K, nt = K / BK, nhalf = 2 * (S.nwg - S.lim);
    unsigned voffA[2], voffB[2];
#pragma unroll
    for (int i = 0; i < 2; ++i) { int R, C; stage_rc(tid * 16 + i * 8192, R, C); const int Rb = Epi::PERM ? ((R & ~31) + perm32(R & 31)) : R;
        voffA[i] = TILED_A ? (unsigned)(R * BK + C) * 2u : (unsigned)(R * K + C) * 2u; voffB[i] = TILED_B ? (unsigned)(Rb * BK + C) * 2u : (unsigned)(Rb * K + C) * 2u; }
    const size_t kstep = (size_t)(BK * 2), hstep = (size_t)HALF * K * 2, tstep = 2 * hstep, kstepT = (size_t)HTB, hstepT = (size_t)nt * HTB;
    const size_t kstepA = TILED_A ? kstepT : kstep, hstepA = TILED_A ? hstepT : hstep, kstepB = TILED_B ? kstepT : kstep, hstepB = TILED_B ? hstepT : hstep;
    const unsigned ldsw = (unsigned)wid * 1024u;
    const int aoff = lds_byte(wr * 64 + fr, fq * 8), boff = lds_byte(wc * 32 + fr, fq * 8);
#define PH_STAGE(bufoff, gbase, voff) do { _Pragma("unroll") for (int _i = 0; _i < 2; ++_i) \
        __builtin_amdgcn_global_load_lds((const unsigned*)((const char*)(gbase) + (voff)[_i]), (PG8_LAS unsigned*)(lds + (bufoff) + ldsw + _i * 8192), 16, 0, 0); } while (0)
#define PH_STAGE3(slot, ka_, kb_) do { PH_STAGE((slot), kb_, voffB); PH_STAGE((slot) + HTB, (kb_) + hstepB, voffB); PH_STAGE((slot) + 2 * HTB, ka_, voffA); } while (0)
#define PH_MMA(bj, At, Bt) do { __builtin_amdgcn_s_setprio(1); _Pragma("unroll") for (int m = 0; m < 4; ++m) _Pragma("unroll") for (int n = 0; n < 2; ++n) _Pragma("unroll") for (int k = 0; k < 2; ++k) \
        acc[0][bj][m][n] = __builtin_amdgcn_mfma_f32_16x16x32_bf16(Bt[n][k], At[m][k], acc[0][bj][m][n], 0, 0, 0); __builtin_amdgcn_s_setprio(0); } while (0)
    for (int h = (int)blockIdx.x; h < nhalf; h += S.G) {
        Unit u; S.unit_at((long)S.lim + (h >> 1), u); const int hsel = h & 1;
        f32x4 acc[2][2][4][2];
#pragma unroll
        for (int b = 0; b < 2; ++b)
#pragma unroll
            for (int m = 0; m < 4; ++m)
#pragma unroll
                for (int n = 0; n < 2; ++n) { acc[0][b][m][n] = (f32x4){0.f, 0.f, 0.f, 0.f}; acc[1][b][m][n] = (f32x4){0.f, 0.f, 0.f, 0.f}; }
        bf16x8 At[4][2], B0[2][2], B1[2][2];
        const char* ka = (const char*)g.A + (size_t)u.pm * tstep + (size_t)hsel * hstepA; const char* kb = (const char*)g.Bt + (size_t)u.pn * tstep;
        PH_STAGE3(0, ka, kb); PH_STAGE3(3 * HTB, ka + kstepA, kb + kstepB);
        asm volatile("s_waitcnt vmcnt(6)" ::: "memory"); __builtin_amdgcn_s_barrier(); __builtin_amdgcn_sched_barrier(0);
        int cur = 0, nxt2 = 6 * HTB;
        for (int t = 0; t < nt; ++t) {
            const bool more = (t + 2 < nt);
            if (more) PH_STAGE3(nxt2, ka + 2 * kstepA, kb + 2 * kstepB);
            const PG8_LAS unsigned char* sl = lds + cur;
#pragma unroll
            for (int n = 0; n < 2; ++n)
#pragma unroll
                for (int k = 0; k < 2; ++k) { B0[n][k] = *(const PG8_LAS bf16x8*)(sl + boff + n * 2048 + k * 1024); B1[n][k] = *(const PG8_LAS bf16x8*)(sl + HTB + boff + n * 2048 + k * 1024); }
#pragma unroll
            for (int m = 0; m < 4; ++m)
#pragma unroll
                for (int k = 0; k < 2; ++k) At[m][k] = *(const PG8_LAS bf16x8*)(sl + 2 * HTB + aoff + m * 2048 + k * 1024);
            asm volatile("s_waitcnt lgkmcnt(0)" ::: "memory"); __builtin_amdgcn_sched_barrier(0);
            PH_MMA(0, At, B0); PH_MMA(1, At, B1);
            if (more) asm volatile("s_waitcnt vmcnt(6)" ::: "memory"); else asm volatile("s_waitcnt vmcnt(0)" ::: "memory");
            __builtin_amdgcn_s_barrier(); __builtin_amdgcn_sched_barrier(0);
            ka += kstepA; kb += kstepB; cur = (cur == 6 * HTB) ? 0 : cur + 3 * HTB; nxt2 = (nxt2 == 6 * HTB) ? 0 : nxt2 + 3 * HTB;
        }
        E.template run<1>(acc, u, wr, wc, fr, fq, hsel * HALF);
    }
    asm volatile("s_waitcnt lgkmcnt(0)" ::: "memory"); __builtin_amdgcn_s_barrier();
#undef PH_STAGE
#undef PH_STAGE3
#undef PH_MMA
}
}
#ifndef ATT_WT
#define ATT_WT 0
#endif
#ifndef SCALE_WT
#define SCALE_WT 0
#endif
#ifndef ROWS_PER_TRIP
#define ROWS_PER_TRIP 8
#endif
namespace dattn {
typedef short bf16x8 __attribute__((ext_vector_type(8)));
typedef short s16x4 __attribute__((ext_vector_type(4)));
typedef float f32x16 __attribute__((ext_vector_type(16)));
typedef unsigned u32x4 __attribute__((ext_vector_type(4)));
#define DA_LAS __attribute__((address_space(3)))
constexpr int SEQ = 8192, NH = 12, HD = 64, DA = NH * HD, NKEY = 384, KROW = 144;
constexpr int TB = 192;
constexpr int LDS_K = 0, K_BYTES = NKEY * KROW, LDS_V = K_BYTES, V_HALF = NKEY * 64, LDS_OST = LDS_V + 2 * V_HALF, LDS_ALLB = LDS_OST + 8 * 4096, LDS_NEG = LDS_ALLB + NH * TB * 4, LDS_END = LDS_NEG + 64 * 4;
constexpr int NUNITS = 2 * NH * 32;
__device__ const unsigned char T5_BUCKET[3][132] = {
 {0,1,2,3,4,5,6,7,8,9,10,11,12,13,14,15,16,16,16,16,16,16,17,17,17,17,17,17,17,17,18,18,18,18,18,18,18,18,18,18,19,19,19,19,19,19,19,19,19,19,19,19,19,19,20,20,20,20,20,20,20,20,20,20,20,20,20,20,20,20,20,20,20,21,21,21,21,21,21,21,21,21,21,21,21,21,21,21,21,21,21,21,21,21,21,21,21,21,21,22,22,22,22,22,22,22,22,22,22,22,22,22,22,22,22,22,22,22,22,22,22,22,22,22,22,22,22,22,22,0,0,0},
 {0,4,8,12,16,16,17,17,18,18,19,19,19,19,20,20,20,20,20,21,21,21,21,21,21,22,22,22,22,22,22,22,22,22,23,23,23,23,23,23,23,23,23,23,23,23,24,24,24,24,24,24,24,24,24,24,24,24,24,24,24,24,25,25,25,25,25,25,25,25,25,25,25,25,25,25,25,25,25,25,25,25,25,26,26,26,26,26,26,26,26,26,26,26,26,26,26,26,26,26,26,26,26,26,26,26,26,26,26,26,26,26,26,27,27,27,27,27,27,27,27,27,27,27,27,27,27,27,27,0,0,0},
 {0,16,18,19,20,21,21,22,22,23,23,23,24,24,24,24,25,25,25,25,25,26,26,26,26,26,26,26,26,27,27,27,27,27,27,27,27,27,27,28,28,28,28,28,28,28,28,28,28,28,28,28,29,29,29,29,29,29,29,29,29,29,29,29,29,29,29,29,29,29,30,30,30,30,30,30,30,30,30,30,30,30,30,30,30,30,30,30,30,30,30,30,30,30,30,31,31,31,31,31,31,31,31,31,31,31,31,31,31,31,31,31,31,31,31,31,31,31,31,31,31,31,31,31,31,31,31,31,31,0,0,0}};
__device__ __forceinline__ int crow(int r, int hi) { return (r & 3) + 8 * (r >> 2) + 4 * hi; }
__device__ __forceinline__ unsigned cvtpk(float lo, float hi) { unsigned r; asm volatile("v_cvt_pk_bf16_f32 %0, %1, %2" : "=v"(r) : "v"(lo), "v"(hi)); return r; }
typedef short v4i16_t __attribute__((ext_vector_type(4)));
__device__ __forceinline__ s16x4 vtr(DA_LAS const char* p) { return __builtin_bit_cast(s16x4, __builtin_amdgcn_ds_read_tr16_b64_v4i16((DA_LAS v4i16_t*)p)); }

struct UnitGeom { int b, h, g, dsh, r, I0; };
__device__ __forceinline__ UnitGeom unit_geom(int unit) {
    UnitGeom u; const int bh = unit >> 5, u32i = unit & 31; u.b = bh / NH; u.h = bh % NH; u.g = u.h >> 2; u.dsh = 2 * u.g;
    const int cps = 32 >> u.dsh;
    u.r = u32i / cps; u.I0 = (u32i % cps) * 256; return u;
}
struct UnitRegs { u32x4 kv[6], vv[6]; bf16x8 qr[4]; };
__device__ __forceinline__ void attn_load(int unit, const unsigned short* Q, const unsigned short* K, const unsigned short* V, UnitRegs& R, int tid) {
    const UnitGeom u = unit_geom(unit); const size_t rowbase = (size_t)u.b * SEQ;
    const int lane = tid & 63, q32 = lane & 31, hi = lane >> 5, wid = tid >> 6;
#pragma unroll
    for (int it = 0; it < 6; ++it) { const int idx = tid + 512 * it, row = idx >> 3, ch = idx & 7, J = u.I0 - 128 + row;
        const int Jc = J < 0 ? 0 : J; const size_t ga = (rowbase + (size_t)((Jc << u.dsh) + u.r)) * DA + u.h * HD + ch * 8;
        R.kv[it] = *(const u32x4*)(K + ga); R.vv[it] = *(const u32x4*)(V + ga); }
    const size_t qtok = rowbase + (size_t)(((u.I0 + 32 * wid + q32) << u.dsh) + u.r);
#pragma unroll
    for (int s = 0; s < 4; ++s) R.qr[s] = __builtin_nontemporal_load((const bf16x8*)(Q + qtok * DA + u.h * HD + s * 16 + hi * 8));
}
__device__ __forceinline__ void attn_stage(int unit, const UnitRegs& R, const float* rel_bias, DA_LAS char* lds, int tid) {
    const UnitGeom u = unit_geom(unit);
#pragma unroll
    for (int it = 0; it < 6; ++it) { const int idx = tid + 512 * it, row = idx >> 3, ch = idx & 7; const bool ok = (u.I0 - 128 + row) >= 0; const u32x4 z = (u32x4){0u, 0u, 0u, 0u};
        *(DA_LAS u32x4*)(lds + LDS_K + row * KROW + ch * 16) = ok ? R.kv[it] : z;
        *(DA_LAS u32x4*)(lds + LDS_V + (ch >> 2) * V_HALF + row * 64 + (ch & 3) * 16) = ok ? R.vv[it] : z; }
}
__device__ __forceinline__ void attn_compute(int unit, const bf16x8 (&qr)[4], unsigned short* O, float* lse2, DA_LAS char* lds, int tid) {
    const int lane = tid & 63, q32 = lane & 31, hi = lane >> 5; const int wid = __builtin_amdgcn_readfirstlane(tid >> 6);
    const UnitGeom ug = unit_geom(unit); const int h = ug.h, dsh = ug.dsh, r = ug.r, I0 = ug.I0;
    const size_t rowbase = (size_t)ug.b * SEQ;
    const int Iq = I0 + 32 * wid + q32;
    const size_t qtok = rowbase + (size_t)((Iq << dsh) + r);
    const int Jw = I0 + 32 * wid - 128;
    const DA_LAS float* bias = (const DA_LAS float*)(lds + LDS_ALLB) + h * TB + (q32 - 4 * hi);
    const DA_LAS float* negt = (const DA_LAS float*)(lds + LDS_NEG) + (q32 - 4 * hi);
    f32x16 st[5];
#pragma unroll
    for (int kt = 0; kt < 5; ++kt) { const DA_LAS char* kp = lds + LDS_K + (32 * (wid + kt) + q32) * KROW + hi * 16;
        const bool tile_ok = (Jw + 32 * kt) >= 0;
        const DA_LAS float* bp = tile_ok ? bias + (160 - 32 * kt) : negt + 32;
        f32x16 a;
#pragma unroll
        for (int i = 0; i < 16; ++i) a[i] = bp[-((i & 3) + 8 * (i >> 2))];
#pragma unroll
        for (int s = 0; s < 4; ++s) { const bf16x8 kf = *(const DA_LAS bf16x8*)(kp + s * 32); a = __builtin_amdgcn_mfma_f32_32x32x16_bf16(kf, qr[s], a, 0, 0, 0); }
        st[kt] = a; }
    float mx = -INFINITY;
#pragma unroll
    for (int kt = 0; kt < 5; ++kt)
#pragma unroll
        for (int i = 0; i < 16; ++i) mx = __builtin_fmaxf(mx, st[kt][i]);
    { auto rr = __builtin_amdgcn_permlane32_swap(__float_as_uint(mx), __float_as_uint(mx), false, false); mx = __builtin_fmaxf(__uint_as_float(rr[0]), __uint_as_float(rr[1])); }
    float den = 0.f;
#pragma unroll
    for (int kt = 0; kt < 5; ++kt)
#pragma unroll
        for (int i = 0; i < 16; ++i) { const float p = __builtin_amdgcn_exp2f(st[kt][i] - mx); st[kt][i] = p; den += p; }
    { auto rr = __builtin_amdgcn_permlane32_swap(__float_as_uint(den), __float_as_uint(den), false, false); den = __uint_as_float(rr[0]) + __uint_as_float(rr[1]); }
    f32x16 o[2]; o[0] = f32x16{}; o[1] = f32x16{};
    const DA_LAS char* vp0 = lds + LDS_V + (32 * wid + 4 * hi + ((lane >> 2) & 3)) * 64 + ((lane >> 4) & 1) * 32 + (lane & 3) * 8;
#pragma unroll
    for (int kt = 0; kt < 5; ++kt)
#pragma unroll
        for (int s2 = 0; s2 < 2; ++s2) { u32x4 pw; pw.x = cvtpk(st[kt][8 * s2 + 0], st[kt][8 * s2 + 1]); pw.y = cvtpk(st[kt][8 * s2 + 2], st[kt][8 * s2 + 3]); pw.z = cvtpk(st[kt][8 * s2 + 4], st[kt][8 * s2 + 5]); pw.w = cvtpk(st[kt][8 * s2 + 6], st[kt][8 * s2 + 7]);
            const bf16x8 pa = __builtin_bit_cast(bf16x8, pw);
#pragma unroll
            for (int dh = 0; dh < 2; ++dh) { const DA_LAS char* vp = vp0 + dh * V_HALF + (32 * kt + 16 * s2) * 64;
                const s16x4 lo = vtr(vp), hv = vtr(vp + 8 * 64);
                const bf16x8 vf = (bf16x8){lo[0], lo[1], lo[2], lo[3], hv[0], hv[1], hv[2], hv[3]};
                o[dh] = __builtin_amdgcn_mfma_f32_32x32x16_bf16(vf, pa, o[dh], 0, 0, 0); } }
    const float rl = __builtin_amdgcn_rcpf(den);
    if (hi == 0) lse2[qtok * NH + h] = mx + __builtin_amdgcn_logf(den);
    DA_LAS char* stg = lds + LDS_OST + wid * 4096;
#pragma unroll
    for (int dh = 0; dh < 2; ++dh)
#pragma unroll
        for (int ig = 0; ig < 4; ++ig) { const unsigned long long pk = (unsigned long long)cvtpk(o[dh][4 * ig] * rl, o[dh][4 * ig + 1] * rl) | ((unsigned long long)cvtpk(o[dh][4 * ig + 2] * rl, o[dh][4 * ig + 3] * rl) << 32);
            *(DA_LAS unsigned long long*)(stg + q32 * 128 + (((4 * dh + ig) ^ (q32 & 7)) * 16) + hi * 8) = pk; }
    asm volatile("s_waitcnt lgkmcnt(0)" ::: "memory");
#pragma unroll
    for (int i = 0; i < 4; ++i) { const int row = i * 8 + (lane >> 3), ch = lane & 7; const u32x4 v = *(const DA_LAS u32x4*)(stg + row * 128 + ((ch ^ (row & 7)) * 16));
        const size_t otok = rowbase + (size_t)(((I0 + 32 * wid + row) << dsh) + r);
#if ATT_WT
        asm volatile("global_store_dwordx4 %0, %1, off sc1\n\ts_nop 1" :: "v"(O + otok * DA + h * HD + ch * 8), "v"(v) : "memory"); }
#else
        *(u32x4*)(O + otok * DA + h * HD + ch * 8) = v; }
#endif
}
__device__ __forceinline__ void attn_phase(int u0, int u1, int u2, int count, int reps, const unsigned short* Q, const unsigned short* K, const unsigned short* V, unsigned short* O, float* lse2, const float* rel_bias, DA_LAS char* lds) {
    const int total = count * reps; if (total <= 0) return;
    int tid = threadIdx.x; asm volatile("" : "+v"(tid));
#define DA_UNIT(k_) ((k_) == 0 ? u0 : ((k_) == 1 ? u1 : u2))
    UnitRegs R; attn_load(u0, Q, K, V, R, tid);
    for (int i = tid; i < NH * TB + 64; i += 512) { const int hh_ = i / TB, dist = i - hh_ * TB - 32; const bool ok = (i < NH * TB) && dist >= 0 && dist <= 128; const int dcl = dist < 0 ? 0 : (dist > 128 ? 128 : dist);
        const float bvl = rel_bias[T5_BUCKET[hh_ < NH ? (hh_ >> 2) : 0][dcl] * NH + (hh_ < NH ? hh_ : 0)] * 1.4426950408889634f;
        ((DA_LAS float*)(lds + LDS_ALLB))[i] = ok ? bvl : -INFINITY; }
    for (int i = 0; i < total; ++i) { const int unit = DA_UNIT(i % count);
        asm volatile("" : "+v"(tid));
        attn_stage(unit, R, rel_bias, lds, tid);
#ifdef ATT_SREP
        for (int sr_ = 0; sr_ < ATT_SREP; ++sr_) { asm volatile("" ::: "memory"); attn_stage(unit, R, rel_bias, lds, tid); }
#endif
        bf16x8 qc[4];
#pragma unroll
        for (int s = 0; s < 4; ++s) qc[s] = R.qr[s];
        __syncthreads();
#ifdef ATT_LREP
        for (int lr_ = 0; lr_ < ATT_LREP; ++lr_) { if (i + 1 < total) attn_load(DA_UNIT((i + 1) % count), Q, K, V, R, tid);
#pragma unroll
            for (int z_ = 0; z_ < 6; ++z_) { asm volatile("" : "+v"(R.kv[z_]), "+v"(R.vv[z_])); }
#pragma unroll
            for (int z_ = 0; z_ < 4; ++z_) { asm volatile("" : "+v"(R.qr[z_])); } }
#endif
#ifndef ATT_LOAD_AFTER
        if (i + 1 < total) attn_load(DA_UNIT((i + 1) % count), Q, K, V, R, tid);
#endif
#ifdef ATT_CREP
        for (int cr_ = 0; cr_ < ATT_CREP; ++cr_) { attn_compute(unit, qc, O, lse2, lds, tid); asm volatile("" ::: "memory"); }
#endif
        attn_compute(unit, qc, O, lse2, lds, tid);
#ifdef ATT_LOAD_AFTER
        asm volatile("" ::: "memory"); __builtin_amdgcn_sched_barrier(0);
        if (i + 1 < total) attn_load(DA_UNIT((i + 1) % count), Q, K, V, R, tid);
#endif
        __syncthreads();
    }
}
constexpr int SR = ROWS_PER_TRIP;
__device__ __forceinline__ void scale_rows(unsigned short* O, const float* lse2, int m_lo, int m_hi, int step, int lane) {
    for (int m0 = m_lo; m0 < m_hi; m0 += SR * step) {
        unsigned long long w[SR][3]; float lv[SR][3][3];
#pragma unroll
        for (int rr = 0; rr < SR; ++rr) { const int m = (m0 + rr * step < m_hi) ? m0 + rr * step : m_lo; const float* l = lse2 + (size_t)m * NH;
#pragma unroll
            for (int k = 0; k < 3; ++k) { const int c = lane + 64 * k, hh = (c >> 4) & 3;
                w[rr][k] = *((const unsigned long long*)(O + (size_t)m * DA) + c); lv[rr][k][0] = l[hh]; lv[rr][k][1] = l[4 + hh]; lv[rr][k][2] = l[8 + hh]; } }
#pragma unroll
        for (int rr = 0; rr < SR; ++rr) { const int m = m0 + rr * step; if (m < m_hi) {
#pragma unroll
            for (int k = 0; k < 3; ++k) { const int c = lane + 64 * k, g = c >> 6;
                const float l0 = lv[rr][k][0], l1 = lv[rr][k][1], l2 = lv[rr][k][2]; const float mm = __builtin_fmaxf(__builtin_fmaxf(l0, l1), l2);
                const float e0 = __builtin_amdgcn_exp2f(l0 - mm), e1 = __builtin_amdgcn_exp2f(l1 - mm), e2 = __builtin_amdgcn_exp2f(l2 - mm);
                const float al = (g == 0 ? e0 : (g == 1 ? e1 : e2)) * __builtin_amdgcn_rcpf(e0 + e1 + e2);
                const unsigned w0 = (unsigned)w[rr][k], w1 = (unsigned)(w[rr][k] >> 32);
                const float f0 = __uint_as_float(w0 << 16) * al, f1 = __uint_as_float(w0 & 0xffff0000u) * al, f2 = __uint_as_float(w1 << 16) * al, f3 = __uint_as_float(w1 & 0xffff0000u) * al;
                const unsigned long long pk_ = (unsigned long long)cvtpk(f0, f1) | ((unsigned long long)cvtpk(f2, f3) << 32);
#if SCALE_WT
                asm volatile("global_store_dwordx2 %0, %1, off sc1\n\ts_nop 1" :: "v"((unsigned long long*)(O + (size_t)m * DA) + c), "v"(pk_) : "memory"); } } }
#else
                *((unsigned long long*)(O + (size_t)m * DA) + c) = pk_; } } }
#endif
    }
}
}
#define GAS __attribute__((address_space(1)))
#define LAS __attribute__((address_space(3)))
typedef unsigned short bf16;
typedef unsigned v4u __attribute__((ext_vector_type(4)));
typedef float f32x4 __attribute__((ext_vector_type(4)));
typedef short bf16x8 __attribute__((ext_vector_type(8)));
typedef GAS unsigned gu32;
typedef GAS unsigned long long gu64;
#define RLX_AGENT __ATOMIC_RELAXED, __HIP_MEMORY_SCOPE_AGENT
#define LDS_WAIT() asm volatile("s_waitcnt lgkmcnt(0)" ::: "memory")
#define VM_WAIT() asm volatile("s_waitcnt vmcnt(0)" ::: "memory")
__device__ __forceinline__ unsigned long long rt() { return __builtin_amdgcn_s_memrealtime(); }
__device__ __forceinline__ unsigned f2bf(float f) { unsigned u = __builtin_bit_cast(unsigned, f); return (u + 0x7fffu + ((u >> 16) & 1u)) >> 16; }
__device__ __forceinline__ unsigned pk2(float lo, float hi) { return f2bf(lo) | (f2bf(hi) << 16); }

#ifndef XB_EARLY_INV
#define XB_EARLY_INV 1
#endif
#ifndef XB_DIRECT_RELEASE
#define XB_DIRECT_RELEASE 1
#endif
#define XB_TMO      128
#define XB_XCNT(j)  (256  + 64 * (j))
#define XB_XSUB(j)  (1280 + 64 * (j))
#define XB_XGEN(j)  (2304 + 64 * (j))
#define XB_TOP      3328
#define XB_TOPGEN   3392
#define XCD_BAR_WORDS 3456
#define XB_SPIN_CAP (1u << 18)

__device__ __forceinline__ unsigned xb_ld(unsigned* p)              { return __hip_atomic_load(p, __ATOMIC_RELAXED, __HIP_MEMORY_SCOPE_AGENT); }
__device__ __forceinline__ unsigned xb_add(unsigned* p, unsigned v) { return __hip_atomic_fetch_add(p, v, __ATOMIC_RELAXED, __HIP_MEMORY_SCOPE_AGENT); }
__device__ __forceinline__ unsigned xb_xcc_id() { return (unsigned)__builtin_amdgcn_s_getreg((3 << 11) | 20) & 0xFu; }
#define XB_SPIN(cond, bar) do { unsigned _sp = 0; while (cond) { __builtin_amdgcn_s_sleep(1); \
    if ((++_sp & 255u) == 0u) { if (xb_ld(&(bar)[XB_TMO])) break; if (_sp > XB_SPIN_CAP) { atomicAdd(&(bar)[XB_TMO], 1u); break; } } } } while (0)

struct XcdBarrier {
    unsigned* bar; unsigned x;
    volatile LAS unsigned* st;
};

__device__ __forceinline__ XcdBarrier xcd_barrier_post(unsigned* bar, volatile LAS unsigned* st) {
    XcdBarrier b; b.bar = bar; b.x = xb_xcc_id(); b.st = st;
    if (threadIdx.x == 0) (void)xb_add(&bar[XB_XCNT(b.x)], 1u);
    return b;
}
__device__ __forceinline__ void xcd_barrier_complete(unsigned* bar, unsigned x, unsigned& nloc, unsigned& nx) {
    const unsigned G = gridDim.x * gridDim.y * gridDim.z;
    unsigned sum, cnt, mine, sp = 0u;
    for (;;) {
        sum = 0u; cnt = 0u; mine = 0u;
#pragma unroll
        for (unsigned j = 0; j < 16; ++j) { const unsigned c = xb_ld(&bar[XB_XCNT(j)]); sum += c; cnt += (c > 0u) ? 1u : 0u; mine = (j == x) ? c : mine; }
        if (sum == G) break;
        __builtin_amdgcn_s_sleep(1);
        if ((++sp & 255u) == 0u) { if (xb_ld(&bar[XB_TMO])) break; if (sp > XB_SPIN_CAP) { atomicAdd(&bar[XB_TMO], 1u); break; } }
    }
    nloc = mine > 0u ? mine : 1u; nx = cnt > 0u ? cnt : 1u;
}

__device__ __forceinline__ void xcd_barrier(const XcdBarrier& b) {
    asm volatile("s_waitcnt vmcnt(0)" ::: "memory");
    __syncthreads();
    if (threadIdx.x == 0) {
        unsigned* bar = b.bar;
        __builtin_amdgcn_s_waitcnt(0);
        unsigned nloc = b.st[0], nx = b.st[1];
        if (nloc == 0u) { xcd_barrier_complete(bar, b.x, nloc, nx); b.st[0] = nloc; b.st[1] = nx; }
        const unsigned old = xb_add(&bar[XB_XSUB(b.x)], 1u);
        const unsigned gen = old / nloc;
        if (old + 1u == (gen + 1u) * nloc) {
            __builtin_amdgcn_fence(__ATOMIC_RELEASE, "agent");
            asm volatile("s_waitcnt vmcnt(0)" ::: "memory");
            const unsigned og = xb_add(&bar[XB_TOP], 1u);
            const unsigned tg = og / nx;
#if XB_DIRECT_RELEASE
            if (og + 1u == (tg + 1u) * nx) {
#pragma unroll
                for (unsigned j = 0; j < 16; ++j) (void)xb_add(&bar[XB_XGEN(j)], 1u); }
#if XB_EARLY_INV
            __builtin_amdgcn_fence(__ATOMIC_ACQUIRE, "agent");
            XB_SPIN(xb_ld(&bar[XB_XGEN(b.x)]) == gen, bar);
            asm volatile("s_waitcnt vmcnt(0)" ::: "memory");
#else
            XB_SPIN(xb_ld(&bar[XB_XGEN(b.x)]) == gen, bar);
            __builtin_amdgcn_fence(__ATOMIC_ACQUIRE, "agent");
            asm volatile("s_waitcnt vmcnt(0)" ::: "memory");
#endif
#else
            if (og + 1u == (tg + 1u) * nx) xb_add(&bar[XB_TOPGEN], 1u);
            else XB_SPIN(xb_ld(&bar[XB_TOPGEN]) == tg, bar);
            __builtin_amdgcn_fence(__ATOMIC_ACQUIRE, "agent");
            xb_add(&bar[XB_XGEN(b.x)], 1u);
            asm volatile("s_waitcnt vmcnt(0)" ::: "memory");
#endif
        } else {
#if XB_EARLY_INV
            __builtin_amdgcn_fence(__ATOMIC_ACQUIRE, "agent");
            XB_SPIN(xb_ld(&bar[XB_XGEN(b.x)]) == gen, bar);
            asm volatile("s_waitcnt vmcnt(0)" ::: "memory");
#else
            XB_SPIN(xb_ld(&bar[XB_XGEN(b.x)]) == gen, bar);
            __builtin_amdgcn_fence(__ATOMIC_ACQUIRE, "agent");
            asm volatile("s_waitcnt vmcnt(0)" ::: "memory");
#endif
        }
    }
    __syncthreads();
}
#ifndef HALF_ROUNDS
#define HALF_ROUNDS false
#endif
constexpr int NWAVES = 8;
constexpr int BATCH = 2, SEQ = 8192, DM = 1024, M = BATCH * SEQ, DEPTH = 4, CONVW = 31, DATT = 768, NHEADS = 12, DFF = 2816;
constexpr size_t MiB = 1u << 20;
constexpr size_t WS_CTL = 0, CTL_ZERO_BYTES = 128 * 1024;
constexpr size_t WS_SSQ = 1 * MiB;
constexpr size_t WS_WPW1 = 4 * MiB, WS_WPW2 = 12 * MiB, WS_WQKV = 16 * MiB, WS_WO = 25 * MiB, WS_WGU = 28 * MiB, WS_WDN = 72 * MiB;
constexpr size_t WS_XB = 94 * MiB;
constexpr size_t WS_R = 126 * MiB;
constexpr size_t WS_LSE = 214 * MiB, WS_O = 215 * MiB, WS_END = 239 * MiB;
constexpr int CW_BAR = 4096, CW_SEAM = 16384;
constexpr int RING_BYTES = 131072, LDS_BYTES = HALF_ROUNDS ? 163840 : 147456, MISC_OFF = LDS_BYTES - 256, STATS_OFF = 131072;
static_assert(!HALF_ROUNDS || pg8::HALF_RING_BYTES <= MISC_OFF, "half-unit ring");
static_assert(dattn::LDS_END <= MISC_OFF, "attention LDS map");

template <int CTRL> __device__ __forceinline__ float dpp_quad(float v) { return __builtin_bit_cast(float, __builtin_amdgcn_update_dpp(0, __builtin_bit_cast(int, v), CTRL, 0xF, 0xF, true)); }
__device__ __forceinline__ float wave_sum(float v) {
#pragma unroll
    for (int o = 1; o < 64; o <<= 1) v += __shfl_xor(v, o);
    return v;
}
__device__ __forceinline__ void transpose_item(const float* W, int ldw, int c0, int k0, const float* gain, bf16* WT, int K, int r0, LAS float* scr, int lane) {
    const int kr = lane >> 4, cq = (lane & 15) * 4;
    const float* src = W + (size_t)(k0 + kr) * ldw + c0 + cq;
    f32x4 v[16];
#pragma unroll
    for (int i = 0; i < 16; ++i) v[i] = __builtin_nontemporal_load((const f32x4*)(src + (size_t)(4 * i) * ldw));
    if (gain) {
#pragma unroll
        for (int i = 0; i < 16; ++i) v[i] = v[i] * gain[k0 + 4 * i + kr]; }
#pragma unroll
    for (int i = 0; i < 16; ++i) { LAS float* d = scr + (4 * i + kr) * 65 + cq; d[0] = v[i].x; d[1] = v[i].y; d[2] = v[i].z; d[3] = v[i].w; }
    LDS_WAIT(); asm volatile("" ::: "memory");
    const int c = lane & 7;
#pragma unroll
    for (int j = 0; j < 8; ++j) { const int n = (lane >> 3) + 8 * j; const LAS float* s = scr + (8 * c) * 65 + n;
        v4u o; o.x = pg8::cvt_pk_bf16(s[0 * 65], s[1 * 65]); o.y = pg8::cvt_pk_bf16(s[2 * 65], s[3 * 65]); o.z = pg8::cvt_pk_bf16(s[4 * 65], s[5 * 65]); o.w = pg8::cvt_pk_bf16(s[6 * 65], s[7 * 65]);
        const int rr = r0 + n;
        bf16* dst = TILED_B ? WT + ((size_t)(rr >> 7) * (K >> 6) + (k0 >> 6)) * 8192 + (rr & 127) * 64 + 8 * c : WT + (size_t)rr * K + k0 + 8 * c;
        *(GAS v4u*)dst = o; }
    LDS_WAIT(); asm volatile("" ::: "memory");
}

#ifndef REP_PROL
#define REP_PROL 1
#endif
#ifndef ATT_STAGGER_TICKS
#define ATT_STAGGER_TICKS 0
#endif
#ifndef CONVERT_SPLIT
#define CONVERT_SPLIT 0
#endif
#ifndef REP_CONVERT
#define REP_CONVERT 1
#endif
#ifndef QHALF
#define QHALF 1
#endif
#ifndef GHALF
#define GHALF 0
#endif
#ifndef PROBE_LDA
#define PROBE_LDA 0
#endif
#ifndef PROBE_K
#define PROBE_K 0
#endif
#ifndef PROBE_EPI_MODE
#define PROBE_EPI_MODE 0
#endif
#ifndef REP_PW1
#define REP_PW1 1
#endif
#ifndef REP_CONV
#define REP_CONV 1
#endif
#ifndef REP_QKV
#define REP_QKV 1
#endif
#ifndef REP_ATT
#define REP_ATT 1
#endif
#ifndef REP_BAR
#define REP_BAR 1
#endif
#ifndef PROBE_RESID
#define PROBE_RESID 0
#endif
#ifndef SPREAD_CONVERT
#define SPREAD_CONVERT 1
#endif
#ifndef GU_ALIGN
#define GU_ALIGN true
#endif
#ifndef GU_SP2
#define GU_SP2 true
#endif
#ifndef REP_PROL_W
#define REP_PROL_W 1
#endif
#ifndef REP_PROL_X
#define REP_PROL_X 1
#endif
#ifndef FUSE_FINAL
#define FUSE_FINAL 0
#endif
#ifndef TILED_H
#define TILED_H false
#endif
#ifndef RESID_ALIGN
#define RESID_ALIGN true
#endif
#ifndef ATT_LOCAL
#define ATT_LOCAL 0
#endif
#ifndef LAST_STAGGER_TICKS
#define LAST_STAGGER_TICKS 0
#endif
#ifndef CONVERT_FIRST
#define CONVERT_FIRST 1
#endif
#ifndef REP_GU
#define REP_GU 1
#endif
struct Args { const float* in[18]; float* out; unsigned char* ws; int ph_lo, ph_hi; };

__device__ __forceinline__ void convert_layer_weights(const Args& a, int layer, LAS unsigned char* lds, int w, int nw, int wave, int lane) {
    LAS float* scr = (LAS float*)(lds + wave * 16640);
    unsigned char* ws = a.ws; const int j = layer >> 1;
    const float* norm_mix = a.in[1] + layer * DM; const float* norm_ffn = a.in[2] + layer * DM;
    constexpr int I_PW1 = 16 * 32, I_PW2 = 16 * 16, I_QKV = 16 * 36, I_WO = 12 * 16, I_GU = 16 * 88, I_DN = 44 * 16, I_MIX = I_PW1 + I_PW2;
    static_assert(I_QKV + I_WO == I_MIX, "items per mixer");
    for (int it = w; it < I_MIX + I_GU + I_DN; it += nw) {
        int r = it;
        if (r < I_MIX) {
            if ((layer & 1) == 0) {
                if (r < I_PW1) { const int kb = r >> 5, nb = r & 31, n0 = nb * 64; const int src = ((n0 >> 7) & 1) * 1024 + (n0 >> 8) * 128 + (n0 & 127);
                    transpose_item(a.in[4] + (size_t)j * 1024 * 2048, 2048, src, kb * 64, norm_mix, (bf16*)(ws + WS_WPW1) + (size_t)j * 2048 * 1024, 1024, n0, scr, lane); }
                else { r -= I_PW1; const int kb = r >> 4, nb = r & 15;
                    transpose_item(a.in[10] + (size_t)j * 1024 * 1024, 1024, nb * 64, kb * 64, nullptr, (bf16*)(ws + WS_WPW2) + (size_t)j * 1024 * 1024, 1024, nb * 64, scr, lane); }
            } else {
                if (r < I_QKV) { const int kb = r / 36, nb = r % 36;
                    transpose_item(a.in[12] + (size_t)j * 1024 * 2304, 2304, nb * 64, kb * 64, norm_mix, (bf16*)(ws + WS_WQKV) + (size_t)j * 2304 * 1024, 1024, nb * 64, scr, lane); }
                else { r -= I_QKV; const int kb = r >> 4, nb = r & 15;
                    transpose_item(a.in[13] + (size_t)j * 768 * 1024, 1024, nb * 64, kb * 64, nullptr, (bf16*)(ws + WS_WO) + (size_t)j * 1024 * 768, 768, nb * 64, scr, lane); }
            }
            continue; }
        r -= I_MIX;
        if (r < I_GU) { const int kb = r / 88, nb = r % 88, n0 = nb * 64;
            const float* W = ((n0 >> 7) & 1) ? a.in[16] : a.in[15]; const int src = (n0 >> 8) * 128 + (n0 & 127);
            transpose_item(W + (size_t)layer * 1024 * DFF, DFF, src, kb * 64, norm_ffn, (bf16*)(ws + WS_WGU) + (size_t)layer * 5632 * 1024, 1024, n0, scr, lane); continue; }
        r -= I_GU;
        { const int kb = r >> 4, nb = r & 15;
            transpose_item(a.in[17] + (size_t)layer * DFF * 1024, 1024, nb * 64, kb * 64, nullptr, (bf16*)(ws + WS_WDN) + (size_t)layer * 1024 * DFF, DFF, nb * 64, scr, lane); }
    }
}
__device__ __forceinline__ void prologue(const Args& a, LAS unsigned char* lds, int gw, int ngw, int wave, int lane) {
    unsigned char* ws = a.ws;
    for (int rw = 0; rw < REP_PROL_W; ++rw) convert_layer_weights(a, 0, lds, gw, ngw, wave, lane);
#if !SPREAD_CONVERT
    for (int l = 1; l < DEPTH; ++l) convert_layer_weights(a, l, lds, gw, ngw, wave, lane);
#endif
    const float* x = a.in[0]; bf16* XB = (bf16*)(ws + WS_XB); pg8::ssq_t* ssq0 = (pg8::ssq_t*)(ws + WS_SSQ);
    const int nwgs = ngw / NWAVES, vblk = gw / NWAVES, rpw = (M + nwgs - 1) / nwgs, row_lo = vblk * rpw, row_hi = (row_lo + rpw < M) ? row_lo + rpw : M;
    { v4u* z = (v4u*)(ssq0 + M);
      for (int i = gw * 64 + lane; i < 8 * M * 8 / 16; i += ngw * 64) z[i] = (v4u){0u, 0u, 0u, 0u}; }
    for (int rx = 0; rx < REP_PROL_X; ++rx)
    for (int m0 = row_lo + (gw % NWAVES) * 4; m0 < row_hi; m0 += NWAVES * 4) {
        f32x4 v[4][4];
#pragma unroll
        for (int rr = 0; rr < 4; ++rr) { const GAS f32x4* xr = (const GAS f32x4*)(x + (size_t)(m0 + rr) * DM) + lane;
#pragma unroll
            for (int j = 0; j < 4; ++j) v[rr][j] = __builtin_nontemporal_load(xr + 64 * j); }
        float s[4];
#pragma unroll
        for (int rr = 0; rr < 4; ++rr) { s[rr] = 0.f;
#pragma unroll
            for (int j = 0; j < 4; ++j) s[rr] += (v[rr][j].x * v[rr][j].x + v[rr][j].y * v[rr][j].y) + (v[rr][j].z * v[rr][j].z + v[rr][j].w * v[rr][j].w); }
#pragma unroll
        for (int o = 1; o < 64; o <<= 1) {
#pragma unroll
            for (int rr = 0; rr < 4; ++rr) s[rr] += __shfl_xor(s[rr], o); }
#pragma unroll
        for (int rr = 0; rr < 4; ++rr) { GAS unsigned long long* o8 = (GAS unsigned long long*)(XB + (size_t)(m0 + rr) * DM) + lane;
#pragma unroll
            for (int j = 0; j < 4; ++j) o8[64 * j] = (unsigned long long)pg8::cvt_pk_bf16(v[rr][j].x, v[rr][j].y) | ((unsigned long long)pg8::cvt_pk_bf16(v[rr][j].z, v[rr][j].w) << 32);
            if (lane == 0) ssq0[m0 + rr] = pg8::ssq_enc(s[rr]); }
    }
}

typedef float f32x2 __attribute__((ext_vector_type(2)));
#ifndef CONV_WT
#define CONV_WT 0
#endif
constexpr int CONV_TT = 64, CONV_ROWS = CONV_TT + 30, CONV_RING = 16;
#define CONV_LOAD(R) (*(const GAS unsigned*)(ubase + (size_t)(((R) < 30 && tb - 30 + (R) < 0) ? 30 - tb : (R)) * (DM * 2)))
#define CONV_ROW(R) { unsigned xw_ = xq[(R) % CONV_RING]; if ((R) < 30 && tb - 30 + (R) < 0) xw_ = 0u; \
    if ((R) + CONV_RING < CONV_ROWS) xq[(R) % CONV_RING] = CONV_LOAD((R) + CONV_RING);     \
    f32x2 xv_; xv_.x = __uint_as_float(xw_ << 16); xv_.y = __uint_as_float(xw_ & 0xffff0000u); \
    _Pragma("unroll") for (int t = ((R) > 30 ? (R) - 30 : 0); t <= ((R) < CONV_TT ? (R) : CONV_TT - 1); ++t) a[t] += w[(R) - t] * xv_; \
    __builtin_amdgcn_sched_barrier(0); }
#define CONV_ROW2(B) CONV_ROW((B)) CONV_ROW((B) + 1)
#define CONV_ROW8(B) CONV_ROW2((B)) CONV_ROW2((B) + 2) CONV_ROW2((B) + 4) CONV_ROW2((B) + 6)
#define CONV_ROW32(B) CONV_ROW8((B)) CONV_ROW8((B) + 8) CONV_ROW8((B) + 16) CONV_ROW8((B) + 24)
__device__ __forceinline__ void conv_phase(const bf16* U, const float* wdw, const float* bdw, const float* lng, const float* lnb, bf16* C, LAS unsigned char* lds, int vcu, int G, int tid_) {
    f32x2 w[CONVW];
    { const int c0 = 2 * tid_;
#pragma unroll
      for (int k = 0; k < CONVW; ++k) w[k] = *(const f32x2*)(wdw + k * DM + c0); }
    constexpr int NT = M / CONV_TT; const int tpw = (NT + G - 1) / G;
    for (int ti = 0; ti < tpw * REP_CONV; ++ti) { const int tile = vcu * tpw + (ti % tpw); if (tile >= NT) break;
        int tid = tid_; asm volatile("" : "+v"(tid));
        const int c0 = 2 * tid, lane = tid & 63, wave = __builtin_amdgcn_readfirstlane(tid >> 6);
        const int m0 = tile * CONV_TT, tb = m0 & (SEQ - 1);
        const char* ubase = (const char*)U + ((ptrdiff_t)(m0 - 30) * DM + c0) * 2;
        const f32x2 bd = *(const f32x2*)(bdw + c0);
        __builtin_amdgcn_sched_barrier(0);
        unsigned xq[CONV_RING];
#pragma unroll
        for (int r = 0; r < CONV_RING; ++r) xq[r] = CONV_LOAD(r);
        __builtin_amdgcn_sched_barrier(0);
        f32x2 a[CONV_TT];
#pragma unroll
        for (int t = 0; t < CONV_TT; ++t) a[t] = bd;
        __builtin_amdgcn_sched_barrier(0);
        CONV_ROW32(0) CONV_ROW32(32) CONV_ROW8(64) CONV_ROW8(72) CONV_ROW8(80) CONV_ROW2(88) CONV_ROW2(90) CONV_ROW2(92)
#pragma unroll
        for (int t = 0; t < CONV_TT; ++t) asm volatile("" : "+v"(a[t]));
        LAS float* P = (LAS float*)lds + (tid >> 2); LAS float* stats = (LAS float*)(lds + 65536);
#pragma unroll
        for (int t = 0; t < CONV_TT; ++t) { float s1 = a[t].x + a[t].y, s2 = a[t].x * a[t].x + a[t].y * a[t].y;
            s1 += dpp_quad<0xB1>(s1); s2 += dpp_quad<0xB1>(s2); s1 += dpp_quad<0x4E>(s1); s2 += dpp_quad<0x4E>(s2);
            if ((tid & 3) == 0) { P[(2 * t) * 128] = s1; P[(2 * t + 1) * 128] = s2; } }
        __syncthreads();
        { const LAS float* Pr = (const LAS float*)lds + wave * 16 * 128 + lane;
          float sv[16];
#pragma unroll
          for (int j = 0; j < 16; ++j) sv[j] = Pr[j * 128] + Pr[j * 128 + 64];
#pragma unroll
          for (int o = 1; o < 64; o <<= 1) {
#pragma unroll
              for (int j = 0; j < 16; ++j) sv[j] += __shfl_xor(sv[j], o); }
          if (lane == 0) {
#pragma unroll
              for (int j = 0; j < 16; j += 2) { const float mean = sv[j] * (1.0f / DM), var = sv[j + 1] * (1.0f / DM) - mean * mean;
                  stats[wave * 16 + j] = mean; stats[wave * 16 + j + 1] = __builtin_amdgcn_rsqf(var + 1e-6f); } } }
        __syncthreads();
        const f32x2 g2 = *(const f32x2*)(lng + c0), b2 = *(const f32x2*)(lnb + c0);
        unsigned* crow = (unsigned*)((char*)C + (size_t)((unsigned)m0 * (DM * 2) + (unsigned)c0 * 2));
#pragma unroll
        for (int t = 0; t < CONV_TT; ++t) { const f32x2 mr = *(const LAS f32x2*)(stats + 2 * t);
            const f32x2 y = (a[t] - mr.x) * (g2 * mr.y) + b2;
            f32x2 e = y * (-1.4426950408889634f); e.x = __builtin_amdgcn_exp2f(e.x); e.y = __builtin_amdgcn_exp2f(e.y); e = e + 1.0f;
            const unsigned cw_ = pg8::cvt_pk_bf16(y.x * __builtin_amdgcn_rcpf(e.x), y.y * __builtin_amdgcn_rcpf(e.y));
#if CONV_WT
            asm volatile("global_store_dword %0, %1, off sc1" :: "v"(crow + t * (DM / 2)), "v"(cw_) : "memory"); }
#else
            crow[t * (DM / 2)] = cw_; }
#endif
        __syncthreads();
    }
}
#undef CONV_ROW32
#undef CONV_ROW8
#undef CONV_ROW2
#undef CONV_ROW
#undef CONV_LOAD

__global__ void __launch_bounds__(NWAVES * 64, 2) trunk_fwd(Args args) {
    extern __shared__ __attribute__((aligned(16))) unsigned char lds[];
    LAS unsigned char* L = (LAS unsigned char*)lds;
    volatile LAS unsigned* MISC = (volatile LAS unsigned*)(L + MISC_OFF);
    const int tid0 = threadIdx.x, wave = __builtin_amdgcn_readfirstlane(tid0 >> 6);
    const int G = gridDim.x, bx = blockIdx.x, vcu = (G % 8 == 0) ? (bx % 8) * (G / 8) + bx / 8 : bx;
    unsigned char* ws = args.ws;
    gu32* ctl = (gu32*)(ws + WS_CTL);
    if (tid0 < 64) MISC[tid0] = 0u;
    __syncthreads();
    XcdBarrier bar = xcd_barrier_post((unsigned*)(ctl + CW_BAR), MISC + 8);
    const int lo = args.ph_lo, hi = args.ph_hi; int pid = 0;
#define PH_BEGIN if (pid >= lo && pid < hi) { int tid = tid0; asm volatile("" : "+v"(tid)); const int lane = tid & 63; (void)lane;
#define PH_END   if (pid + 1 < hi) { for (int rb = 0; rb < REP_BAR; ++rb) xcd_barrier(bar); } } ++pid;
    bf16* XB = (bf16*)(ws + WS_XB); pg8::ssq_t* SSQ = (pg8::ssq_t*)(ws + WS_SSQ);
    bf16* R0 = (bf16*)(ws + WS_R);
    const int gw = vcu * NWAVES + wave, ngw = G * NWAVES;

    PH_BEGIN for (int rep = 0; rep < REP_PROL; ++rep) prologue(args, L, gw, ngw, wave, lane); PH_END

    for (int layer = 0; layer < DEPTH; ++layer) {
        const int j = layer >> 1;
        if ((layer & 1) == 0) {
            bf16* U = R0; bf16* C = R0 + (size_t)M * DM;
            PH_BEGIN
                pg8::Gemm g{XB, (const bf16*)(ws + WS_WPW1) + (size_t)j * 2048 * 1024, M, 2048, 1024, false}; pg8::StaticOrder S; S.init(M, 2048, G, bx);
                pg8::EpiGate<0> E{U, DM, SSQ + (size_t)layer * M, args.in[5] + j * 2048, false};
                for (int rep = 0; rep < REP_PW1; ++rep) { pg8::EpiGate<0> E2 = E; E2.probe = (rep + 1 < REP_PW1) ? PROBE_EPI_MODE : 0; pg8::Gemm g2 = g; if (PROBE_K > 0 && rep + 1 < REP_PW1) g2.K = PROBE_K; if (PROBE_LDA > 0 && rep + 1 < REP_PW1) g2.lda = PROBE_LDA; pg8::gemm_phase<pg8::EpiGate<0>, pg8::StaticOrder, true, true>(L, g2, S, E2); }
            PH_END
            PH_BEGIN
                conv_phase(U, args.in[6] + (size_t)j * CONVW * DM, args.in[7] + j * DM, args.in[8] + j * DM, args.in[9] + j * DM, C, L, vcu, G, tid);
            PH_END
            PH_BEGIN
                pg8::Gemm g{C, (const bf16*)(ws + WS_WPW2) + (size_t)j * 1024 * 1024, M, 1024, 1024, false}; pg8::StaticOrder S; S.init(M, 1024, G, bx);
                if (PROBE_RESID & 1) { pg8::EpiResid<false, true> E{nullptr, XB, U, DM, args.in[11] + j * DM, SSQ + (size_t)12 * M};
                    pg8::gemm_phase<pg8::EpiResid<false, true>, pg8::StaticOrder, RESID_ALIGN, true>(L, g, S, E); }
                if (layer == 0) { pg8::EpiResid<true, true> E{args.in[0], XB, XB, DM, args.in[11] + j * DM, SSQ + (size_t)(4 + layer) * M};
                    pg8::gemm_phase<pg8::EpiResid<true, true>, pg8::StaticOrder, RESID_ALIGN, true>(L, g, S, E); }
                else { pg8::EpiResid<false, true> E{nullptr, XB, XB, DM, args.in[11] + j * DM, SSQ + (size_t)(4 + layer) * M};
                    pg8::gemm_phase<pg8::EpiResid<false, true>, pg8::StaticOrder, RESID_ALIGN, true>(L, g, S, E); }
            PH_END
        } else {
            bf16* Qb = R0; bf16* Kb = R0 + (size_t)M * DATT; bf16* Vb = R0 + 2 * (size_t)M * DATT; float* LSE = (float*)(ws + WS_LSE); bf16* Ob = (bf16*)(ws + WS_O);
            PH_BEGIN
                const bool qhalf = HALF_ROUNDS && QHALF;
                pg8::Gemm g{XB, (const bf16*)(ws + WS_WQKV) + (size_t)j * 2304 * 1024, M, 2304, 1024, false}; pg8::StaticOrder S; S.init(M, 2304, G, bx, qhalf);
                pg8::EpiQkv E{Qb, DATT, SSQ + (size_t)layer * M, DATT, (size_t)M * DATT, 0.125f * 1.4426950408889634f};
                for (int rep = 0; rep < REP_QKV; ++rep) { pg8::gemm_phase<pg8::EpiQkv, pg8::StaticOrder, true, true>(L, g, S, E); if (qhalf) pg8::gemm_half_phase<pg8::EpiQkv>(L, g, S, E); }
#if SPREAD_CONVERT
                if (false) {
                    const int rem = S.nwg % G, nidle = G - rem;
                    if (bx >= rem) convert_layer_weights(args, layer + 1, L, (bx - rem) * NWAVES + wave, nidle * NWAVES, wave, lane); }
#endif
            PH_END
            PH_BEGIN
                if (ATT_LOCAL && G == 256) {
                    const int x = bx & 7, w = bx >> 3, b = x >> 2, xq = x & 3; int ul[3];
#pragma unroll
                    for (int i = 0; i < 3; ++i) { const int lid = 3 * w + i; int h, u32i;
                        if (lid < 32) { h = lid >> 3; u32i = 8 * xq + (lid & 7); }
                        else if (lid < 64) { const int l = lid - 32, rem = l & 7; h = 4 + (l >> 3); u32i = (rem >> 1) * 8 + 2 * xq + (rem & 1); }
                        else { const int l = lid - 64; h = 8 + (l >> 3); u32i = (8 * (xq & 1) + (l & 7)) * 2 + (xq >> 1); }
                        ul[i] = (b * 12 + h) * 32 + u32i; }
                    dattn::attn_phase(ul[0], ul[1], ul[2], 3, REP_ATT, Qb, Kb, Vb, Ob, LSE, args.in[14], (LAS char*)L);
                } else {
                if (ATT_STAGGER_TICKS > 0 && ((bx >> 3) & 1)) {
                    const unsigned long long t0 = __builtin_amdgcn_s_memrealtime(); while (__builtin_amdgcn_s_memrealtime() - t0 < (unsigned long long)ATT_STAGGER_TICKS) __builtin_amdgcn_s_sleep(4); }
                const int upw = (dattn::NUNITS + G - 1) / G, first = vcu * upw, cnt = (first + upw <= dattn::NUNITS) ? upw : (dattn::NUNITS - first);
                for (int i0 = 0; i0 < cnt; i0 += 3) dattn::attn_phase(first + i0, first + i0 + 1, first + i0 + 2, (cnt - i0 < 3) ? cnt - i0 : 3, REP_ATT, Qb, Kb, Vb, Ob, LSE, args.in[14], (LAS char*)L); }
            PH_END
            PH_BEGIN
                { const int rpw = (M + G - 1) / G, row_lo = vcu * rpw, row_hi = (row_lo + rpw < M) ? row_lo + rpw : M; dattn::scale_rows(Ob, LSE, row_lo + wave, row_hi, NWAVES, lane); }
            PH_END
            PH_BEGIN
                pg8::Gemm g{Ob, (const bf16*)(ws + WS_WO) + (size_t)j * 1024 * 768, M, 1024, 768, false}; pg8::StaticOrder S; S.init(M, 1024, G, bx);
                if (PROBE_RESID & 2) { pg8::EpiResid<false, false> E{nullptr, XB, Qb, DM, nullptr, SSQ + (size_t)12 * M};
                    pg8::gemm_phase<pg8::EpiResid<false, false>, pg8::StaticOrder, RESID_ALIGN, true>(L, g, S, E); }
                pg8::EpiResid<false, false> E{nullptr, XB, XB, DM, nullptr, SSQ + (size_t)(4 + layer) * M};
                pg8::gemm_phase<pg8::EpiResid<false, false>, pg8::StaticOrder, RESID_ALIGN, true>(L, g, S, E);
            PH_END
        }
        bf16* H = R0;
        PH_BEGIN
            const bool ghalf = HALF_ROUNDS && GHALF && (layer + 1 >= DEPTH);
            pg8::Gemm g{XB, (const bf16*)(ws + WS_WGU) + (size_t)layer * 5632 * 1024, M, 5632, 1024, false}; pg8::StaticOrder S; S.init(M, 5632, G, bx, ghalf);
            pg8::EpiGate<1> E{H, DFF, SSQ + (size_t)(4 + layer) * M, nullptr, TILED_H};
#if SPREAD_CONVERT && CONVERT_FIRST
            if (layer + 1 < DEPTH && !ghalf) { const int rem = S.nwg % G, nidle = G - rem;
                if (bx >= rem) { for (int rc_ = 0; rc_ < REP_CONVERT; ++rc_) {
                    if (CONVERT_SPLIT) convert_layer_weights(args, layer + 1, L, (bx - rem) * NWAVES + wave, 2 * nidle * NWAVES, wave, lane);
                    else convert_layer_weights(args, layer + 1, L, (bx - rem) * NWAVES + wave, nidle * NWAVES, wave, lane);
                    __syncthreads(); } } }
            if (LAST_STAGGER_TICKS > 0 && layer + 1 >= DEPTH && !ghalf) { const int rem = S.nwg % G;
                if (rem != 0 && bx >= rem) { const unsigned long long t0 = __builtin_amdgcn_s_memrealtime(); while (__builtin_amdgcn_s_memrealtime() - t0 < (unsigned long long)LAST_STAGGER_TICKS) __builtin_amdgcn_s_sleep(8); } }
#endif
            for (int rep = 0; rep < REP_GU; ++rep) { pg8::gemm_phase<pg8::EpiGate<1>, pg8::StaticOrder, GU_ALIGN, GU_SP2>(L, g, S, E); if (ghalf) pg8::gemm_half_phase<pg8::EpiGate<1>>(L, g, S, E); }
#if SPREAD_CONVERT && CONVERT_FIRST
            if (CONVERT_SPLIT && layer + 1 < DEPTH && !ghalf) { const int rem = S.nwg % G, nidle = G - rem;
                if (bx >= rem) convert_layer_weights(args, layer + 1, L, (bx - rem) * NWAVES + wave + nidle * NWAVES, 2 * nidle * NWAVES, wave, lane); }
#endif
#if SPREAD_CONVERT && !CONVERT_FIRST
            if (layer + 1 < DEPTH && !ghalf) {
                const int rem = S.nwg % G, nidle = G - rem;
                if (bx >= rem) convert_layer_weights(args, layer + 1, L, (bx - rem) * NWAVES + wave, nidle * NWAVES, wave, lane); }
#endif
        PH_END
        PH_BEGIN
            pg8::Gemm g{H, (const bf16*)(ws + WS_WDN) + (size_t)layer * 1024 * DFF, M, 1024, DFF, TILED_H}; pg8::StaticOrder S; S.init(M, 1024, G, bx);
            if (PROBE_RESID & 4) { pg8::EpiResid<false, false> E{nullptr, XB, (bf16*)(ws + WS_LSE), DM, nullptr, SSQ + (size_t)12 * M};
                pg8::gemm_phase<pg8::EpiResid<false, false>, pg8::StaticOrder, RESID_ALIGN, true>(L, g, S, E); }
            if (FUSE_FINAL && layer == DEPTH - 1 && G >= (M / 256) * 4) {
                pg8::EpiFinal E{XB, args.out, DM, args.in[3], SSQ + (size_t)8 * M, (unsigned*)(ctl + CW_SEAM), (LAS unsigned*)(L + MISC_OFF + 64), 32u};
                pg8::gemm_phase<pg8::EpiFinal, pg8::StaticOrder, true, true>(L, g, S, E); }
            else {
            pg8::EpiResid<false, false> E{nullptr, XB, XB, DM, nullptr, SSQ + (size_t)(layer == DEPTH - 1 ? 8 : layer + 1) * M};
            pg8::gemm_phase<pg8::EpiResid<false, false>, pg8::StaticOrder, RESID_ALIGN, true>(L, g, S, E); }
        PH_END
    }
    PH_BEGIN
        const float* fn = args.in[3]; const pg8::ssq_t* ssq = SSQ + (size_t)8 * M; float* out = args.out;
        const int rpw = (M + G - 1) / G, row_lo = vcu * rpw, row_hi = (row_lo + rpw < M) ? row_lo + rpw : M;
        for (int m0 = row_lo + wave; m0 < row_hi; m0 += ROWS_PER_TRIP * NWAVES) {
            unsigned long long wv[ROWS_PER_TRIP][4]; float rsv[ROWS_PER_TRIP];
#pragma unroll
            for (int rr = 0; rr < ROWS_PER_TRIP; ++rr) { const int m = (m0 + rr * NWAVES < row_hi) ? m0 + rr * NWAVES : row_lo; rsv[rr] = pg8::rstd_of(ssq + m);
                const GAS unsigned long long* xr = (const GAS unsigned long long*)(XB + (size_t)m * DM) + lane;
#pragma unroll
                for (int q = 0; q < 4; ++q) wv[rr][q] = __builtin_nontemporal_load(xr + 64 * q); }
#pragma unroll
            for (int rr = 0; rr < ROWS_PER_TRIP; ++rr) { const int m = m0 + rr * NWAVES; if (m < row_hi) { GAS f32x4* orow = (GAS f32x4*)(out + (size_t)m * DM) + lane;
#pragma unroll
                for (int q = 0; q < 4; ++q) { const unsigned w0 = (unsigned)wv[rr][q], w1 = (unsigned)(wv[rr][q] >> 32); const f32x4 gq = *((const f32x4*)fn + lane + 64 * q);
                    const f32x4 v = (f32x4){__uint_as_float(w0 << 16), __uint_as_float(w0 & 0xffff0000u), __uint_as_float(w1 << 16), __uint_as_float(w1 & 0xffff0000u)};
                    __builtin_nontemporal_store(v * rsv[rr] * gq, orow + 64 * q); } } } }
    PH_END
#undef PH_BEGIN
#undef PH_END
}

constexpr int N_PHASES = 1 + 2 * 5 + 2 * 6 + 1;
#ifndef MK_PER_PHASE
#define MK_PER_PHASE 0
#endif
extern "C" void kernel_launch(void* const* d_in, const int* in_sizes, int n_in, void* d_out, int out_size, void* d_ws, size_t ws_size, hipStream_t stream) {
    static int grid = 0;
    if (grid == 0) {
        if (n_in != 18 || in_sizes[0] != M * DM || out_size != M * DM || ws_size < WS_END) { fprintf(stderr, "kernel_launch: unexpected shapes (n_in %d, in0 %d, out %d, ws %zu); nothing launched\n", n_in, n_in > 0 ? in_sizes[0] : -1, out_size, ws_size); grid = -1; return; }
        int dev = 0, cus = 0, per_cu = 0;
        if (hipGetDevice(&dev) != hipSuccess || hipDeviceGetAttribute(&cus, hipDeviceAttributeMultiprocessorCount, dev) != hipSuccess) { grid = -1; return; }
        if (hipFuncSetAttribute((const void*)trunk_fwd, hipFuncAttributeMaxDynamicSharedMemorySize, LDS_BYTES) != hipSuccess) { fprintf(stderr, "kernel_launch: hipFuncSetAttribute failed\n"); grid = -1; return; }
        if (hipOccupancyMaxActiveBlocksPerMultiprocessor(&per_cu, (const void*)trunk_fwd, NWAVES * 64, LDS_BYTES) != hipSuccess || per_cu < 1) { fprintf(stderr, "kernel_launch: occupancy query says %d blocks per CU\n", per_cu); }
        (void)hipGetLastError();
        grid = cus;
    }
    if (grid < 0) return;
    (void)hipMemsetAsync((char*)d_ws + WS_CTL, 0, CTL_ZERO_BYTES, stream);
    Args a{};
    for (int i = 0; i < 18; ++i) a.in[i] = (const float*)d_in[i];
    a.out = (float*)d_out; a.ws = (unsigned char*)d_ws;
#if MK_PER_PHASE
    for (int p = 0; p < N_PHASES; ++p) { a.ph_lo = p; a.ph_hi = p + 1; hipLaunchKernelGGL(trunk_fwd, dim3(grid), dim3(NWAVES * 64), LDS_BYTES, stream, a); }
#else
    a.ph_lo = 0; a.ph_hi = N_PHASES - ((FUSE_FINAL && grid >= (M / 256) * 4) ? 1 : 0); hipLaunchKernelGGL(trunk_fwd, dim3(grid), dim3(NWAVES * 64), LDS_BYTES, stream, a);
#endif
}
```

```cpp
#include <hip/hip_runtime.h>
#include <cstdio>
#include <cstdint>
#include <cmath>
#ifndef PG8_WGM
#define PG8_WGM 8
#endif
namespace pg8 {
#define PG8_LAS __attribute__((address_space(3)))
typedef unsigned short bf16_t;
typedef short bf16x8 __attribute__((ext_vector_type(8)));
typedef float f32x4 __attribute__((ext_vector_type(4)));
typedef unsigned u32x4 __attribute__((ext_vector_type(4)));
constexpr int BM = 256, BK = 64, HALF = 128, HTB = HALF * BK * 2  , STAGE_BYTES = 8 * HTB, NXCD = 8, WGM = PG8_WGM;

__host__ __device__ __forceinline__ int lds_byte(int r, int c) { const int st = (r >> 4) * 2 + (c >> 5), rr = r & 15, cc = c & 31, ob = rr * 64 + cc * 2; return st * 1024 + (ob ^ (((ob >> 9) & 1) << 5)); }
__host__ __device__ __forceinline__ void stage_rc(int b, int& R, int& C) { const int st = b / 1024, sb = b % 1024, swz = sb ^ (((sb >> 9) & 1) << 5); R = (st >> 1) * 16 + swz / 64; C = (st & 1) * 32 + (swz % 64) / 2; }
__host__ __device__ __forceinline__ int perm32(int rho) { const int n = rho >> 4, i = rho & 15; return 8 * (i >> 2) + 4 * n + (i & 3); }

struct Unit { int pm, pn; };
struct Gemm { const bf16_t* A; const bf16_t* Bt; int M, N, K; bool tiledA; int lda = 0; };
__host__ __device__ __forceinline__ size_t tiled_off(int row, int col, int K) { return ((size_t)(row >> 7) * (K >> 6) + (col >> 6)) * 8192 + (size_t)((row & 127) * 64 + (col & 63)); }

struct StaticOrder {
    int nM, nN, nwg, G, c, lim;
    __host__ __device__ void init(int M, int N, int G_, int c_, bool whole_rounds_only = false) { nM = M / BM; nN = N / BM; nwg = nM * nN; G = G_; c = c_; lim = whole_rounds_only ? (nwg / G) * G : nwg; }
    __host__ __device__ bool unit_at(long L, Unit& u) const {
        int wgid = (int)L; { const int q = nwg / NXCD, r = nwg % NXCD, xcd = wgid % NXCD, off = wgid / NXCD; wgid = (xcd < r ? xcd * (q + 1) : r * (q + 1) + (xcd - r) * q) + off; }
        const int nig = WGM * nN, gid = wgid / nig, fm = gid * WGM, gsz = (nM - fm) < WGM ? (nM - fm) : WGM;
        u.pm = fm + ((wgid % nig) % gsz); u.pn = (wgid % nig) / gsz; return true;
    }
    __host__ __device__ bool next(int i, Unit& u) const {
        const long L = (long)i * G + c; if (L >= lim) return false;
        int wgid = (int)L; { const int q = nwg / NXCD, r = nwg % NXCD, xcd = wgid % NXCD, off = wgid / NXCD; wgid = (xcd < r ? xcd * (q + 1) : r * (q + 1) + (xcd - r) * q) + off; }
        const int nig = WGM * nN, gid = wgid / nig, fm = gid * WGM, gsz = (nM - fm) < WGM ? (nM - fm) : WGM;
        u.pm = fm + ((wgid % nig) % gsz); u.pn = (wgid % nig) / gsz; return true;
    }
    __device__ __forceinline__ void a_ready(const Unit&) const {}
    __device__ __forceinline__ void done(const Unit&) const {}
};

__device__ __forceinline__ unsigned cvt_pk_bf16(float lo, float hi) { unsigned r; asm volatile("v_cvt_pk_bf16_f32 %0, %1, %2" : "=v"(r) : "v"(lo), "v"(hi)); return r; }
typedef float f32x2 __attribute__((ext_vector_type(2)));
#ifndef REP_EPI_GU
#define REP_EPI_GU 1
#endif
typedef unsigned u32x2 __attribute__((ext_vector_type(2)));
#ifndef NT_STORES
#define NT_STORES 0
#endif
#ifndef WT_STORES
#define WT_STORES 0
#endif
#ifndef LAST_UNIT_WT
#define LAST_UNIT_WT 0
#endif
#ifndef QKV_NT
#define QKV_NT 0
#endif
#ifndef RESID_WT
#define RESID_WT 1
#endif
__device__ __forceinline__ void store16_resid(void* p, u32x4 v) {
#if RESID_WT
    asm volatile("global_store_dwordx4 %0, %1, off sc1\n\ts_nop 1" :: "v"(p), "v"(v) : "memory");
#else
    *(u32x4*)p = v;
#endif
}
__device__ __forceinline__ void store16_sel(void* p, u32x4 v, bool wt) {
    if (wt) asm volatile("global_store_dwordx4 %0, %1, off sc1\n\ts_nop 1" :: "v"(p), "v"(v) : "memory");
    else *(u32x4*)p = v;
}
__device__ __forceinline__ void store16_out(void* p, u32x4 v) {
#if WT_STORES
    asm volatile("global_store_dwordx4 %0, %1, off sc1\n\ts_nop 1" :: "v"(p), "v"(v) : "memory");
#elif NT_STORES
    __builtin_nontemporal_store(v, (u32x4*)p);
#else
    *(u32x4*)p = v;
#endif
}
constexpr float RMS_EPS = 1e-6f, INV_DM = 1.0f / 1024.0f, LOG2E_F = 1.4426950408889634f;
typedef unsigned long long ssq_t;
constexpr float SSQ_SCALE = 1073741824.0f, SSQ_INV = 1.0f / 1073741824.0f;
__device__ __forceinline__ ssq_t ssq_enc(float s) { return (ssq_t)(s * SSQ_SCALE); }
__device__ __forceinline__ float rstd_of(const ssq_t* p) { return __builtin_amdgcn_rsqf((float)(*p) * (SSQ_INV * INV_DM) + RMS_EPS); }
template <int NAI> __device__ __forceinline__ void load_rstd8(const ssq_t* ssq, int row0, int fr, int fq, float sc, float (&rsv)[8]) {
    const float v0 = rstd_of(ssq + row0 + fq * 16) * sc, v1 = (NAI == 2) ? rstd_of(ssq + row0 + HALF + fq * 16) * sc : 0.f;
#pragma unroll
    for (int m = 0; m < 4; ++m) { rsv[m] = __shfl(v0, fr + 16 * m); rsv[4 + m] = (NAI == 2) ? __shfl(v1, fr + 16 * m) : 0.f; }
}
template <int NAI> __device__ __forceinline__ void load_rstd8_lds(PG8_LAS const ssq_t* ls, int rloc, int fr, int fq, float sc, float (&rsv)[8]) {
    const ssq_t s0 = ls[rloc + fq * 16], s1 = (NAI == 2) ? ls[rloc + HALF + fq * 16] : 0ull;
    const float v0 = __builtin_amdgcn_rsqf((float)s0 * (SSQ_INV * INV_DM) + RMS_EPS) * sc, v1 = (NAI == 2) ? __builtin_amdgcn_rsqf((float)s1 * (SSQ_INV * INV_DM) + RMS_EPS) * sc : 0.f;
#pragma unroll
    for (int m = 0; m < 4; ++m) { rsv[m] = __shfl(v0, fr + 16 * m); rsv[4 + m] = (NAI == 2) ? __shfl(v1, fr + 16 * m) : 0.f; }
}
#ifndef SSQ_PREFETCH
#define SSQ_PREFETCH 0
#endif
__device__ __forceinline__ float sigmoid_f(float x) { return __builtin_amdgcn_rcpf(1.0f + __builtin_amdgcn_exp2f(-LOG2E_F * x)); }

template <int MODE> struct EpiGate {
    static constexpr bool PERM = true, AFTER_DRAIN = false, RESID_PF = false, SSQ_PF = (SSQ_PREFETCH != 0), LAST_WT = (LAST_UNIT_WT != 0); static constexpr int REPS = (MODE == 1) ? REP_EPI_GU : 1;
    bf16_t* O; int ldc; const ssq_t* ssq; const float* bias; bool tiledO; bool wt = false; int probe = 0;
    __device__ __forceinline__ void operator()(const f32x4 (&acc)[2][2][4][2], const Unit& u, int wr, int wc, int fr, int fq) const { run<2>(acc, u, wr, wc, fr, fq, 0); }
    __device__ __forceinline__ void with_lds_ssq(const f32x4 (&acc)[2][2][4][2], const Unit& u, int wr, int wc, int fr, int fq, PG8_LAS const ssq_t* ls) const { run<2>(acc, u, wr, wc, fr, fq, 0, ls); }
    template <int NAI> __device__ __forceinline__ void run(const f32x4 (&acc)[2][2][4][2], const Unit& u, int wr, int wc, int fr, int fq, int rshift, PG8_LAS const ssq_t* ls = nullptr) const {
        if (probe == 1) return;
        const int row0 = u.pm * BM + rshift + wr * 64 + fr, col0 = u.pn * HALF + wc * 32 + 8 * fq;
        f32x4 b0[2], b1[2];
#pragma unroll
        for (int n = 0; n < 2; ++n) {
            if (MODE == 0) { b0[n] = *(const f32x4*)(bias + col0 + 4 * n); b1[n] = *(const f32x4*)(bias + 1024 + col0 + 4 * n); }
            else { b0[n] = (f32x4){0.f, 0.f, 0.f, 0.f}; b1[n] = b0[n]; } }
        float rsv[8]; if (ls) load_rstd8_lds<NAI>(ls, rshift + wr * 64 + fr, fr, fq, 1.0f, rsv); else load_rstd8<NAI>(ssq, row0, fr, fq, 1.0f, rsv);
#pragma unroll
        for (int ai = 0; ai < NAI; ++ai)
#pragma unroll
            for (int m = 0; m < 4; ++m) { const int row = row0 + ai * HALF + m * 16;
                const float rs = rsv[ai * 4 + m];
                u32x4 w; unsigned wv[4];
#pragma unroll
                for (int n = 0; n < 2; ++n) { f32x4 o, t, r;
                    if (MODE == 0) { const f32x4 p = acc[ai][0][m][n] * rs + b0[n]; t = (acc[ai][1][m][n] * rs + b1[n]) * (-LOG2E_F);
#pragma unroll
                        for (int i = 0; i < 4; ++i) t[i] = __builtin_amdgcn_exp2f(t[i]);
                        t = t + 1.0f;
#pragma unroll
                        for (int i = 0; i < 4; ++i) r[i] = __builtin_amdgcn_rcpf(t[i]);
                        o = p * r; }
                    else { t = acc[ai][0][m][n] * (rs * -LOG2E_F);
#pragma unroll
                        for (int i = 0; i < 4; ++i) t[i] = __builtin_amdgcn_exp2f(t[i]);
                        t = t + 1.0f;
#pragma unroll
                        for (int i = 0; i < 4; ++i) r[i] = __builtin_amdgcn_rcpf(t[i]);
                        o = (acc[ai][0][m][n] * acc[ai][1][m][n]) * (rs * rs) * r; }
                    wv[2 * n] = cvt_pk_bf16(o[0], o[1]); wv[2 * n + 1] = cvt_pk_bf16(o[2], o[3]); }
                w.x = wv[0]; w.y = wv[1]; w.z = wv[2]; w.w = wv[3];
                if (probe == 2) asm volatile("" :: "v"(w)); else store16_sel(tiledO ? O + tiled_off(row, col0, ldc) : O + (size_t)row * ldc + col0, w, wt); }
    }
};
struct EpiQkv {
    static constexpr bool PERM = true, AFTER_DRAIN = false, RESID_PF = false, SSQ_PF = (SSQ_PREFETCH != 0), LAST_WT = (LAST_UNIT_WT != 0); static constexpr int REPS = 1;
    bf16_t* O; int ldc; const ssq_t* ssq; int split_cols; size_t split_stride; float scale0; bool wt = false;
    __device__ __forceinline__ void operator()(const f32x4 (&acc)[2][2][4][2], const Unit& u, int wr, int wc, int fr, int fq) const { run<2>(acc, u, wr, wc, fr, fq, 0); }
    __device__ __forceinline__ void with_lds_ssq(const f32x4 (&acc)[2][2][4][2], const Unit& u, int wr, int wc, int fr, int fq, PG8_LAS const ssq_t* ls) const { run<2>(acc, u, wr, wc, fr, fq, 0, ls); }
    template <int NAI> __device__ __forceinline__ void run(const f32x4 (&acc)[2][2][4][2], const Unit& u, int wr, int wc, int fr, int fq, int rshift, PG8_LAS const ssq_t* ls = nullptr) const {
        const int row0 = u.pm * BM + rshift + wr * 64 + fr; int colt = u.pn * BM; bf16_t* base = O;
        float sc = 1.f; { const int t = colt / split_cols; base += (size_t)t * split_stride; colt -= t * split_cols; if (t == 0) sc = scale0; }
        const int col0 = colt + wc * 32 + 8 * fq;
        float rsv[8]; if (ls) load_rstd8_lds<NAI>(ls, rshift + wr * 64 + fr, fr, fq, sc, rsv); else load_rstd8<NAI>(ssq, row0, fr, fq, sc, rsv);
#pragma unroll
        for (int ai = 0; ai < NAI; ++ai)
#pragma unroll
            for (int m = 0; m < 4; ++m) { const int row = row0 + ai * HALF + m * 16;
                const float rs = rsv[ai * 4 + m];
                bf16_t* rowp = base + (size_t)row * ldc + col0;
#pragma unroll
                for (int bj = 0; bj < 2; ++bj) { const f32x4 v0 = acc[ai][bj][m][0] * rs, v1 = acc[ai][bj][m][1] * rs;
                    u32x4 w; w.x = cvt_pk_bf16(v0[0], v0[1]); w.y = cvt_pk_bf16(v0[2], v0[3]); w.z = cvt_pk_bf16(v1[0], v1[1]); w.w = cvt_pk_bf16(v1[2], v1[3]);
#if QKV_NT
                    __builtin_nontemporal_store(w, (u32x4*)(rowp + bj * HALF)); } }
#else
                    store16_sel(rowp + bj * HALF, w, wt); } }
#endif
    }
};
#ifndef RESID_PREFETCH
#define RESID_PREFETCH 1
#endif
template <bool BASE_F32, bool HAS_BIAS> struct EpiResid {
    static constexpr bool PERM = true, AFTER_DRAIN = false, RESID_PF = !BASE_F32 && (RESID_PREFETCH != 0), SSQ_PF = false, LAST_WT = false; static constexpr int REPS = 1;
    static constexpr int NB = BASE_F32 ? 2 : (HAS_BIAS ? 4 : 8);
    const float* basef; const bf16_t* xin; bf16_t* xb; int ldc; const float* bias; ssq_t* ssq_out;
    __device__ __forceinline__ void operator()(const f32x4 (&acc)[2][2][4][2], const Unit& u, int wr, int wc, int fr, int fq) const {
        const int row0 = u.pm * BM + wr * 64 + fr, col0 = u.pn * BM + wc * 32 + 8 * fq;
        f32x4 bv[2][2];
#pragma unroll
        for (int bj = 0; bj < 2; ++bj)
#pragma unroll
            for (int n = 0; n < 2; ++n) bv[bj][n] = HAS_BIAS ? *(const f32x4*)(bias + col0 + bj * HALF + n * 4) : (f32x4){0.f, 0.f, 0.f, 0.f};
        unsigned eoff0 = (unsigned)row0 * (unsigned)ldc + (unsigned)col0;
#pragma unroll
        for (int qb = 0; qb < 8; qb += NB) { asm volatile("" : "+v"(eoff0));
            u32x4 raw[NB][2]; f32x4 rawf[NB][2][2];
#pragma unroll
            for (int k = 0; k < NB; ++k) { const int q = qb + k; const unsigned eo = eoff0 + (unsigned)((q >> 2) * HALF + (q & 3) * 16) * (unsigned)ldc;
#pragma unroll
                for (int bj = 0; bj < 2; ++bj) {
                    if (BASE_F32) { rawf[k][bj][0] = *(const f32x4*)(basef + eo + bj * HALF); rawf[k][bj][1] = *(const f32x4*)(basef + eo + bj * HALF + 4); }
                    else raw[k][bj] = *(const u32x4*)(xin + eo + bj * HALF); } }
#pragma unroll
            for (int k = 0; k < NB; ++k) { const int q = qb + k, ai = q >> 2, m = q & 3; const unsigned eo = eoff0 + (unsigned)(ai * HALF + m * 16) * (unsigned)ldc;
                const int row = row0 + ai * HALF + m * 16; float s = 0.f;
#pragma unroll
                for (int bj = 0; bj < 2; ++bj) { f32x4 b0, b1;
                    if (BASE_F32) { b0 = rawf[k][bj][0]; b1 = rawf[k][bj][1]; }
                    else { const u32x4 w = raw[k][bj];
                        b0 = (f32x4){__uint_as_float(w.x << 16), __uint_as_float(w.x & 0xffff0000u), __uint_as_float(w.y << 16), __uint_as_float(w.y & 0xffff0000u)};
                        b1 = (f32x4){__uint_as_float(w.z << 16), __uint_as_float(w.z & 0xffff0000u), __uint_as_float(w.w << 16), __uint_as_float(w.w & 0xffff0000u)}; }
                    const f32x4 o0 = b0 + acc[ai][bj][m][0] + bv[bj][0], o1 = b1 + acc[ai][bj][m][1] + bv[bj][1];
                    u32x4 w; w.x = cvt_pk_bf16(o0[0], o0[1]); w.y = cvt_pk_bf16(o0[2], o0[3]); w.z = cvt_pk_bf16(o1[0], o1[1]); w.w = cvt_pk_bf16(o1[2], o1[3]);
                    store16_resid(xb + eo + bj * HALF, w);
                    s += (o0[0] * o0[0] + o0[1] * o0[1]) + (o0[2] * o0[2] + o0[3] * o0[3]) + (o1[0] * o1[0] + o1[1] * o1[1]) + (o1[2] * o1[2] + o1[3] * o1[3]); }
                s += __shfl_xor(s, 16); s += __shfl_xor(s, 32);
                if (fq == 0) atomicAdd(ssq_out + row, ssq_enc(s)); }
            asm volatile("" ::: "memory"); }
    }
    __device__ __forceinline__ unsigned pf_voff(const Unit& u, int wr, int wc, int fr, int fq) const {
        return ((unsigned)(u.pm * BM + wr * 64 + fr) * (unsigned)ldc + (unsigned)(u.pn * BM + wc * 32 + 8 * fq)) * 2u; }
    __device__ __forceinline__ const char* pf_base(int j) const { return (const char*)xin + (size_t)((j >> 2) * HALF + (j & 3) * 16) * (size_t)ldc * 2; }
    __device__ __forceinline__ void pf(const f32x4 (&acc)[2][2][4][2], const Unit& u, int wr, int wc, int fr, int fq, PG8_LAS unsigned char* lds, int wid, int lane) const {
        const int row0 = u.pm * BM + wr * 64 + fr, col0 = u.pn * BM + wc * 32 + 8 * fq;
        f32x4 bv[2][2];
#pragma unroll
        for (int bj = 0; bj < 2; ++bj)
#pragma unroll
            for (int n = 0; n < 2; ++n) bv[bj][n] = HAS_BIAS ? *(const f32x4*)(bias + col0 + bj * HALF + n * 4) : (f32x4){0.f, 0.f, 0.f, 0.f};
        const unsigned eoff0 = (unsigned)row0 * (unsigned)ldc + (unsigned)col0;
        u32x4 r7[2];
#pragma unroll
        for (int bj = 0; bj < 2; ++bj) r7[bj] = *(const u32x4*)(xin + eoff0 + (unsigned)(HALF + 48) * (unsigned)ldc + bj * HALF);
        const unsigned lo = (unsigned)wid * 1024u + (unsigned)lane * 16u;
#pragma unroll
        for (int qb = 0; qb < 8; qb += 4) {
            u32x4 raw[4][2];
#pragma unroll
            for (int k = 0; k < 4; ++k) { const int q = qb + k;
                const int slot = q == 0 ? 4 : q == 1 ? 5 : q == 2 ? 0 : q == 3 ? 1 : q == 4 ? 6 : q == 5 ? 7 : 2;
#pragma unroll
                for (int bj = 0; bj < 2; ++bj) { if (q < 7) raw[k][bj] = *(const PG8_LAS u32x4*)(lds + slot * HTB + bj * 8192 + lo); else raw[k][bj] = r7[bj]; } }
#pragma unroll
            for (int k = 0; k < 4; ++k) { const int q = qb + k, ai = q >> 2, m = q & 3; const unsigned eo = eoff0 + (unsigned)(ai * HALF + m * 16) * (unsigned)ldc;
                const int row = row0 + ai * HALF + m * 16; float s = 0.f;
#pragma unroll
                for (int bj = 0; bj < 2; ++bj) { const u32x4 w0 = raw[k][bj];
                    const f32x4 b0 = (f32x4){__uint_as_float(w0.x << 16), __uint_as_float(w0.x & 0xffff0000u), __uint_as_float(w0.y << 16), __uint_as_float(w0.y & 0xffff0000u)};
                    const f32x4 b1 = (f32x4){__uint_as_float(w0.z << 16), __uint_as_float(w0.z & 0xffff0000u), __uint_as_float(w0.w << 16), __uint_as_float(w0.w & 0xffff0000u)};
                    const f32x4 o0 = b0 + acc[ai][bj][m][0] + bv[bj][0], o1 = b1 + acc[ai][bj][m][1] + bv[bj][1];
                    u32x4 w; w.x = cvt_pk_bf16(o0[0], o0[1]); w.y = cvt_pk_bf16(o0[2], o0[3]); w.z = cvt_pk_bf16(o1[0], o1[1]); w.w = cvt_pk_bf16(o1[2], o1[3]);
                    store16_resid(xb + eo + bj * HALF, w);
                    s += (o0[0] * o0[0] + o0[1] * o0[1]) + (o0[2] * o0[2] + o0[3] * o0[3]) + (o1[0] * o1[0] + o1[1] * o1[1]) + (o1[2] * o1[2] + o1[3] * o1[3]); }
                s += __shfl_xor(s, 16); s += __shfl_xor(s, 32);
                if (fq == 0) atomicAdd(ssq_out + row, ssq_enc(s)); } }
    }
};

struct EpiFinal {
    static constexpr bool PERM = true, AFTER_DRAIN = false, RESID_PF = false, SSQ_PF = false, LAST_WT = false; static constexpr int REPS = 1;
    const bf16_t* xin; float* out; int ldc; const float* gain; ssq_t* ssq; unsigned* cnt; PG8_LAS unsigned* flag; unsigned want;
    __device__ __forceinline__ void operator()(const f32x4 (&acc_)[2][2][4][2], const Unit& u, int wr, int wc, int fr, int fq) const {
        f32x4 (&acc)[2][2][4][2] = const_cast<f32x4 (&)[2][2][4][2]>(acc_);
        const int row0 = u.pm * BM + wr * 64 + fr, col0 = u.pn * BM + wc * 32 + 8 * fq, lane = fr + 16 * fq, wid = wr * 4 + wc;
        unsigned eoff0 = (unsigned)row0 * (unsigned)ldc + (unsigned)col0;
#pragma unroll
        for (int qb = 0; qb < 8; qb += 4) { asm volatile("" : "+v"(eoff0));
            u32x4 raw[4][2];
#pragma unroll
            for (int k = 0; k < 4; ++k) { const int q = qb + k; const unsigned eo = eoff0 + (unsigned)((q >> 2) * HALF + (q & 3) * 16) * (unsigned)ldc;
#pragma unroll
                for (int bj = 0; bj < 2; ++bj) raw[k][bj] = *(const u32x4*)(xin + eo + bj * HALF); }
#pragma unroll
            for (int k = 0; k < 4; ++k) { const int q = qb + k, ai = q >> 2, m = q & 3; const int row = row0 + ai * HALF + m * 16; float s = 0.f;
#pragma unroll
                for (int bj = 0; bj < 2; ++bj) { const u32x4 w = raw[k][bj];
                    const f32x4 b0 = (f32x4){__uint_as_float(w.x << 16), __uint_as_float(w.x & 0xffff0000u), __uint_as_float(w.y << 16), __uint_as_float(w.y & 0xffff0000u)};
                    const f32x4 b1 = (f32x4){__uint_as_float(w.z << 16), __uint_as_float(w.z & 0xffff0000u), __uint_as_float(w.w << 16), __uint_as_float(w.w & 0xffff0000u)};
                    const f32x4 o0 = b0 + acc[ai][bj][m][0], o1 = b1 + acc[ai][bj][m][1]; acc[ai][bj][m][0] = o0; acc[ai][bj][m][1] = o1;
                    s += (o0[0] * o0[0] + o0[1] * o0[1]) + (o0[2] * o0[2] + o0[3] * o0[3]) + (o1[0] * o1[0] + o1[1] * o1[1]) + (o1[2] * o1[2] + o1[3] * o1[3]); }
                s += __shfl_xor(s, 16); s += __shfl_xor(s, 32);
                if (fq == 0) atomicAdd(ssq + row, ssq_enc(s)); }
            asm volatile("" ::: "memory"); }
        asm volatile("s_waitcnt vmcnt(0)" ::: "memory");
        if (lane == 0) __hip_atomic_fetch_add(cnt + 64 * u.pm, 1u, __ATOMIC_RELAXED, __HIP_MEMORY_SCOPE_AGENT);
        if (wid == 0) {
            const unsigned long long t0 = __builtin_amdgcn_s_memrealtime();
            for (;;) {
                if ((unsigned)__builtin_amdgcn_readfirstlane(__hip_atomic_load(cnt + 64 * u.pm, __ATOMIC_RELAXED, __HIP_MEMORY_SCOPE_AGENT)) >= want) break;
                if (__builtin_amdgcn_s_memrealtime() - t0 > 2000000ull) break;
                __builtin_amdgcn_s_sleep(2); }
            __builtin_amdgcn_fence(__ATOMIC_ACQUIRE, "agent");
        }
        asm volatile("s_waitcnt vmcnt(0) lgkmcnt(0)" ::: "memory"); __builtin_amdgcn_s_barrier(); asm volatile("" ::: "memory");
        float rsv[8];
        { const ssq_t t0 = __hip_atomic_load(ssq + row0 + fq * 16, __ATOMIC_RELAXED, __HIP_MEMORY_SCOPE_AGENT), t1 = __hip_atomic_load(ssq + row0 + HALF + fq * 16, __ATOMIC_RELAXED, __HIP_MEMORY_SCOPE_AGENT);
          const float v0 = __builtin_amdgcn_rsqf((float)t0 * (SSQ_INV * INV_DM) + RMS_EPS), v1 = __builtin_amdgcn_rsqf((float)t1 * (SSQ_INV * INV_DM) + RMS_EPS);
#pragma unroll
          for (int m = 0; m < 4; ++m) { rsv[m] = __shfl(v0, fr + 16 * m); rsv[4 + m] = __shfl(v1, fr + 16 * m); } }
        f32x4 gv[2][2];
#pragma unroll
        for (int bj = 0; bj < 2; ++bj)
#pragma unroll
            for (int n = 0; n < 2; ++n) gv[bj][n] = *(const f32x4*)(gain + col0 + bj * HALF + n * 4);
#pragma unroll
        for (int ai = 0; ai < 2; ++ai)
#pragma unroll
            for (int m = 0; m < 4; ++m) { const float rs = rsv[ai * 4 + m]; float* orow = out + (size_t)(row0 + ai * HALF + m * 16) * ldc + col0;
#pragma unroll
                for (int bj = 0; bj < 2; ++bj)
#pragma unroll
                    for (int n = 0; n < 2; ++n) __builtin_nontemporal_store(acc[ai][bj][m][n] * rs * gv[bj][n], (f32x4*)(orow + bj * HALF + n * 4)); }
    }
};
#ifndef STATIC_PRIO
#define STATIC_PRIO 0
#endif
#ifndef TILED_A
#define TILED_A false
#endif
#ifndef TILED_B
#define TILED_B true
#endif
template <class Epi, class Sched, bool ALIGN_EPI = false, bool SP2 = false>
__device__ __forceinline__ void gemm_phase(PG8_LAS unsigned char* lds, const Gemm g, const Sched& S, const Epi& E) {
    int tid = threadIdx.x; asm volatile("" : "+v"(tid));
    const int wid = __builtin_amdgcn_readfirstlane(tid >> 6), lane = tid & 63, wr = wid >> 2, wc = wid & 3, fr = lane & 15, fq = lane >> 4;
    const int K = g.K, nt = K / BK, LDA = g.lda ? g.lda : K;
    unsigned voffA[2], voffB[2];
#pragma unroll
    for (int i = 0; i < 2; ++i) { int R, C; stage_rc(tid * 16 + i * 8192, R, C); const int Rb = Epi::PERM ? ((R & ~31) + perm32(R & 31)) : R;
        voffA[i] = g.tiledA ? (unsigned)(R * BK + C) * 2u : (unsigned)(R * LDA + C) * 2u; voffB[i] = TILED_B ? (unsigned)(Rb * BK + C) * 2u : (unsigned)(Rb * K + C) * 2u; }
    const size_t kstep = (size_t)(BK * 2);
    const size_t hstep = (size_t)HALF * K * 2;
    const size_t tstep = 2 * hstep;
    const size_t hstepAr = (size_t)HALF * LDA * 2, tstepA = g.tiledA ? tstep : 2 * hstepAr;
    const size_t kstepT = (size_t)HTB, hstepT = (size_t)nt * HTB;
    const size_t kstepA = g.tiledA ? kstepT : kstep, hstepA = g.tiledA ? hstepT : hstepAr, kstepB = TILED_B ? kstepT : kstep, hstepB = TILED_B ? hstepT : hstep;
    const unsigned ldsw = (unsigned)wid * 1024u;
    const int aoff = lds_byte(wr * 64 + fr, fq * 8), boff = lds_byte(wc * 32 + fr, fq * 8);
#define PG8_SA(b, h) (((b) * 2 + (h)) * HTB)
#define PG8_SB(b, h) ((4 + (b) * 2 + (h)) * HTB)
#define PG8_STAGE(bufoff, gbase, voff) do { _Pragma("unroll") for (int _i = 0; _i < 2; ++_i) \
        __builtin_amdgcn_global_load_lds((const unsigned*)((const char*)(gbase) + (voff)[_i]), (PG8_LAS unsigned*)(lds + (bufoff) + ldsw + _i * 8192), 16, 0, 0); } while (0)
#define PG8_SSQ_DMA(slot_, pm_) do { if (wid < 2) __builtin_amdgcn_global_load_lds((const unsigned*)((const char*)(E.ssq + (size_t)(pm_) * BM) + wid * 1024 + lane * 16), (PG8_LAS unsigned*)(lds + STAGE_BYTES + (slot_) * 2048 + wid * 1024), 16, 0, 0); } while (0)
#define PG8_LDA(dst, b, h) do { _Pragma("unroll") for (int m = 0; m < 4; ++m) _Pragma("unroll") for (int k = 0; k < 2; ++k) dst[m][k] = *(const PG8_LAS bf16x8*)(lds + PG8_SA(b, h) + aoff + m * 2048 + k * 1024); } while (0)
#define PG8_LDB(dst, b, h) do { _Pragma("unroll") for (int n = 0; n < 2; ++n) _Pragma("unroll") for (int k = 0; k < 2; ++k) dst[n][k] = *(const PG8_LAS bf16x8*)(lds + PG8_SB(b, h) + boff + n * 2048 + k * 1024); } while (0)
#define PG8_MMA(ai, bj, At, Bt) do { if (!STATIC_PRIO) __builtin_amdgcn_s_setprio(1); _Pragma("unroll") for (int m = 0; m < 4; ++m) _Pragma("unroll") for (int n = 0; n < 2; ++n) _Pragma("unroll") for (int k = 0; k < 2; ++k) \
        acc[ai][bj][m][n] = __builtin_amdgcn_mfma_f32_16x16x32_bf16(Bt[n][k], At[m][k], acc[ai][bj][m][n], 0, 0, 0); if (!STATIC_PRIO) __builtin_amdgcn_s_setprio(0); } while (0)
#define PG8_WAIT_V(n) asm volatile("s_waitcnt vmcnt(" #n ")" ::: "memory")
#define PG8_WAIT_L(n) asm volatile("s_waitcnt lgkmcnt(" #n ")" ::: "memory")
#define PG8_BAR __builtin_amdgcn_s_barrier()
#define PG8_SCHED __builtin_amdgcn_sched_barrier(0)
    if (STATIC_PRIO) { if (wid >= 4) __builtin_amdgcn_s_setprio(1); }
    Unit cur, nxt; int ui = 0;
    if (!S.next(0, cur)) return;
    f32x4 acc[2][2][4][2];
#pragma unroll
    for (int a = 0; a < 2; ++a)
#pragma unroll
        for (int b = 0; b < 2; ++b)
#pragma unroll
            for (int m = 0; m < 4; ++m)
#pragma unroll
                for (int n = 0; n < 2; ++n) acc[a][b][m][n] = (f32x4){0.f, 0.f, 0.f, 0.f};
    bf16x8 At[4][2], B0[2][2], B1[2][2];
    const char* cA = (const char*)g.A + (size_t)cur.pm * tstepA; const char* cB = (const char*)g.Bt + (size_t)cur.pn * tstep;
    S.a_ready(cur);
    if constexpr (Epi::SSQ_PF) PG8_SSQ_DMA(0, cur.pm);
    if constexpr (SP2) {
        PG8_STAGE(PG8_SB(0, 0), cB, voffB); PG8_STAGE(PG8_SB(0, 1), cB + hstepB, voffB); PG8_STAGE(PG8_SA(0, 0), cA, voffA); PG8_STAGE(PG8_SA(0, 1), cA + hstepA, voffA);
        if (wr == 1) PG8_BAR;
        PG8_WAIT_V(2); PG8_BAR;
        PG8_STAGE(PG8_SB(1, 0), cB + kstepB, voffB); PG8_STAGE(PG8_SA(1, 0), cA + kstepA, voffA); PG8_STAGE(PG8_SB(1, 1), cB + hstepB + kstepB, voffB);
        PG8_WAIT_V(6); PG8_BAR;
    } else {
        PG8_STAGE(PG8_SB(0, 0), cB, voffB); PG8_STAGE(PG8_SA(0, 0), cA, voffA); PG8_STAGE(PG8_SB(0, 1), cB + hstepB, voffB); PG8_STAGE(PG8_SA(0, 1), cA + hstepA, voffA);
        if (wr == 1) PG8_BAR;
        PG8_WAIT_V(4); PG8_BAR;
        PG8_STAGE(PG8_SB(1, 0), cB + kstepB, voffB); PG8_STAGE(PG8_SA(1, 0), cA + kstepA, voffA); PG8_STAGE(PG8_SB(1, 1), cB + hstepB + kstepB, voffB);
        PG8_WAIT_V(6); PG8_BAR;
    }
    for (;;) {
        const bool has_next = S.next(ui + 1, nxt);
        const char* nA = has_next ? (const char*)g.A + (size_t)nxt.pm * tstepA : cA; const char* nB = has_next ? (const char*)g.Bt + (size_t)nxt.pn * tstep : cB;
        for (int t = 0; t < nt; t += 2) {
            const bool last = (t == nt - 2);
            const char* a1 = cA + (size_t)(t + 1) * kstepA;
            const char* a2 = last ? nA : cA + (size_t)(t + 2) * kstepA; const char* b2 = last ? nB : cB + (size_t)(t + 2) * kstepB;
            const char* a3 = a2 + kstepA; const char* b3 = b2 + kstepB;
            if (last && has_next) { S.a_ready(nxt); if constexpr (Epi::SSQ_PF) PG8_SSQ_DMA((ui + 1) & 1, nxt.pm); }
            unsigned wB[2] = {voffB[0], voffB[1]}, wA[2] = {voffA[0], voffA[1]};
            const char *s0 = b2, *s1 = b2 + hstepB, *s2 = a2, *s3 = a2 + hstepA, *s4 = b3, *s5 = b3 + hstepB, *s6 = a3;
            if constexpr (SP2 && Epi::RESID_PF) { if (last && !has_next) {
                int t2 = threadIdx.x; asm volatile("" : "+v"(t2));
                const unsigned v0 = E.pf_voff(cur, wr, wc, t2 & 15, (t2 & 63) >> 4), v1 = v0 + (unsigned)(HALF * 2);
                wB[0] = v0; wB[1] = v1; wA[0] = v0; wA[1] = v1;
                s0 = E.pf_base(0); s1 = E.pf_base(1); s2 = E.pf_base(2); s3 = E.pf_base(3); s4 = E.pf_base(4); s5 = E.pf_base(5); s6 = E.pf_base(6); } }
            if constexpr (SP2) {
            PG8_LDB(B0, 0, 0); PG8_LDB(B1, 0, 1); PG8_SCHED; PG8_LDA(At, 0, 0); PG8_STAGE(PG8_SA(1, 1), a1 + hstepA, voffA);
            PG8_WAIT_V(8); PG8_WAIT_L(0); PG8_BAR; PG8_MMA(0, 0, At, B0); PG8_MMA(0, 1, At, B1); PG8_BAR; PG8_SCHED;
            PG8_LDA(At, 0, 1); PG8_STAGE(PG8_SB(0, 0), s0, wB); PG8_STAGE(PG8_SB(0, 1), s1, wB); PG8_STAGE(PG8_SA(0, 0), s2, wA);
            PG8_WAIT_V(8); PG8_WAIT_L(0); PG8_BAR; PG8_MMA(1, 0, At, B0); PG8_MMA(1, 1, At, B1); PG8_BAR; PG8_SCHED;
            PG8_LDB(B0, 1, 0); PG8_LDB(B1, 1, 1); PG8_SCHED; PG8_LDA(At, 1, 0); PG8_STAGE(PG8_SA(0, 1), s3, wA);
            PG8_WAIT_V(8); PG8_WAIT_L(0); PG8_BAR; PG8_MMA(0, 0, At, B0); PG8_MMA(0, 1, At, B1); PG8_BAR; PG8_SCHED;
            PG8_LDA(At, 1, 1); PG8_STAGE(PG8_SB(1, 0), s4, wB); PG8_STAGE(PG8_SB(1, 1), s5, wB); PG8_STAGE(PG8_SA(1, 0), s6, wA);
            PG8_WAIT_V(8); PG8_WAIT_L(0); PG8_BAR; PG8_MMA(1, 0, At, B0); PG8_MMA(1, 1, At, B1); PG8_BAR; PG8_SCHED;
            } else {
            PG8_LDB(B0, 0, 0); PG8_SCHED; PG8_LDA(At, 0, 0); PG8_STAGE(PG8_SA(1, 1), a1 + hstepA, voffA);
            PG8_WAIT_L(8); PG8_BAR; PG8_WAIT_L(0); PG8_MMA(0, 0, At, B0); PG8_BAR; PG8_SCHED;
            PG8_LDB(B1, 0, 1); PG8_STAGE(PG8_SB(0, 0), b2, voffB);
            PG8_BAR; PG8_WAIT_L(0); PG8_MMA(0, 1, At, B1); PG8_BAR;
            PG8_LDA(At, 0, 1); PG8_STAGE(PG8_SA(0, 0), a2, voffA);
            PG8_BAR; PG8_WAIT_L(0); PG8_MMA(1, 0, At, B0); PG8_BAR; PG8_SCHED;
            PG8_STAGE(PG8_SB(0, 1), b2 + hstepB, voffB);
            PG8_WAIT_V(6); PG8_BAR; PG8_MMA(1, 1, At, B1); PG8_BAR;
            PG8_LDB(B0, 1, 0); PG8_SCHED; PG8_LDA(At, 1, 0); PG8_STAGE(PG8_SA(0, 1), a2 + hstepA, voffA);
            PG8_WAIT_L(8); PG8_BAR; PG8_WAIT_L(0); PG8_MMA(0, 0, At, B0); PG8_BAR; PG8_SCHED;
            PG8_LDB(B1, 1, 1); PG8_STAGE(PG8_SB(1, 0), b3, voffB);
            PG8_BAR; PG8_WAIT_L(0); PG8_MMA(0, 1, At, B1); PG8_BAR;
            PG8_LDA(At, 1, 1); PG8_STAGE(PG8_SA(1, 0), a3, voffA);
            PG8_BAR; PG8_WAIT_L(0); PG8_MMA(1, 0, At, B0); PG8_BAR; PG8_SCHED;
            PG8_STAGE(PG8_SB(1, 1), b3 + hstepB, voffB);
            PG8_WAIT_V(6); PG8_BAR; PG8_MMA(1, 1, At, B1); PG8_BAR;
            }
        }
        if constexpr (ALIGN_EPI) { if (wr == 0) PG8_BAR; }
        if constexpr (SP2 && Epi::RESID_PF) { if (!has_next) { PG8_WAIT_V(0); E.pf(acc, cur, wr, wc, fr, fq, lds, wid, lane); } else E(acc, cur, wr, wc, fr, fq); S.done(cur); }
        else if constexpr (Epi::SSQ_PF) { for (int re_ = 0; re_ < Epi::REPS; ++re_) { E.with_lds_ssq(acc, cur, wr, wc, fr, fq, (PG8_LAS const ssq_t*)(lds + STAGE_BYTES + (ui & 1) * 2048)); asm volatile("" ::: "memory"); } S.done(cur); }
        else if constexpr (Epi::LAST_WT) { Epi E2 = E; E2.wt = !has_next; for (int re_ = 0; re_ < Epi::REPS; ++re_) { E2(acc, cur, wr, wc, fr, fq); asm volatile("" ::: "memory"); } S.done(cur); }
        else if constexpr (!Epi::AFTER_DRAIN) { for (int re_ = 0; re_ < Epi::REPS; ++re_) { E(acc, cur, wr, wc, fr, fq); asm volatile("" ::: "memory"); } S.done(cur);
#ifdef EPI_DRAIN_PROBE
            PG8_WAIT_V(0);
#endif
        }
        if (!has_next) break;
#pragma unroll
        for (int a = 0; a < 2; ++a)
#pragma unroll
            for (int b = 0; b < 2; ++b)
#pragma unroll
                for (int m = 0; m < 4; ++m)
#pragma unroll
                    for (int n = 0; n < 2; ++n) acc[a][b][m][n] = (f32x4){0.f, 0.f, 0.f, 0.f};
        cur = nxt; cA = nA; cB = nB; ++ui;
        if constexpr (ALIGN_EPI) { if (wr == 1) PG8_BAR; }
    }
    if (STATIC_PRIO) __builtin_amdgcn_s_setprio(0);
    PG8_WAIT_V(0);
    if constexpr (!ALIGN_EPI) { if (wr == 0) PG8_BAR; }
    PG8_BAR;
    if constexpr (Epi::AFTER_DRAIN) { E.fused(acc, cur, wr, wc, fr, fq, lds, wid, lane); S.done(cur); }
#undef PG8_SA
#undef PG8_SB
#undef PG8_STAGE
#undef PG8_SSQ_DMA
#undef PG8_LDA
#undef PG8_LDB
#undef PG8_MMA
#undef PG8_WAIT_V
#undef PG8_WAIT_L
#undef PG8_BAR
#undef PG8_SCHED
}
constexpr int HALF_RING_BYTES = 3 * 3 * HTB;
template <class Epi>
__device__ __forceinline__ void gemm_half_phase(PG8_LAS unsigned char* lds, const Gemm g, const StaticOrder& S, const Epi& E) {
    int tid = threadIdx.x; asm volatile("" : "+v"(tid));
    const int wid = __builtin_amdgcn_readfirstlane(tid >> 6), lane = tid & 63, wr = wid >> 2, wc = wid & 3, fr = lane & 15, fq = lane >> 4;
    const int K = g.K, nt = K / BK, nhalf = 2 * (S.nwg - S.lim);
    unsigned voffA[2], voffB[2];
#pragma unroll
    for (int i = 0; i < 2; ++i) { int R, C; stage_rc(tid * 16 + i * 8192, R, C); const int Rb = Epi::PERM ? ((R & ~31) + perm32(R & 31)) : R;
        voffA[i] = TILED_A ? (unsigned)(R * BK + C) * 2u : (unsigned)(R * K + C) * 2u; voffB[i] = TILED_B ? (unsigned)(Rb * BK + C) * 2u : (unsigned)(Rb * K + C) * 2u; }
    const size_t kstep = (size_t)(BK * 2), hstep = (size_t)HALF * K * 2, tstep = 2 * hstep, kstepT = (size_t)HTB, hstepT = (size_t)nt * HTB;
    const size_t kstepA = TILED_A ? kstepT : kstep, hstepA = TILED_A ? hstepT : hstep, kstepB = TILED_B ? kstepT : kstep, hstepB = TILED_B ? hstepT : hstep;
    const unsigned ldsw = (unsigned)wid * 1024u;
    const int aoff = lds_byte(wr * 64 + fr, fq * 8), boff = lds_byte(wc * 32 + fr, fq * 8);
#define PH_STAGE(bufoff, gbase, voff) do { _Pragma("unroll") for (int _i = 0; _i < 2; ++_i) \
        __builtin_amdgcn_global_load_lds((const unsigned*)((const char*)(gbase) + (voff)[_i]), (PG8_LAS unsigned*)(lds + (bufoff) + ldsw + _i * 8192), 16, 0, 0); } while (0)
#define PH_STAGE3(slot, ka_, kb_) do { PH_STAGE((slot), kb_, voffB); PH_STAGE((slot) + HTB, (kb_) + hstepB, voffB); PH_STAGE((slot) + 2 * HTB, ka_, voffA); } while (0)
#define PH_MMA(bj, At, Bt) do { __builtin_amdgcn_s_setprio(1); _Pragma("unroll") for (int m = 0; m < 4; ++m) _Pragma("unroll") for (int n = 0; n < 2; ++n) _Pragma("unroll") for (int k = 0; k < 2; ++k) \
        acc[0][bj][m][n] = __builtin_amdgcn_mfma_f32_16x16x32_bf16(Bt[n][k], At[m][k], acc[0][bj][m][n], 0, 0, 0); __builtin_amdgcn_s_setprio(0); } while (0)
    for (int h = (int)blockIdx.x; h < nhalf; h += S.G) {
        Unit u; S.unit_at((long)S.lim + (h >> 1), u); const int hsel = h & 1;
        f32x4 acc[2][2][4][2];
#pragma unroll
        for (int b = 0; b < 2; ++b)
#pragma unroll
            for (int m = 0; m < 4; ++m)
#pragma unroll
                for (int n = 0; n < 2; ++n) { acc[0][b][m][n] = (f32x4){0.f, 0.f, 0.f, 0.f}; acc[1][b][m][n] = (f32x4){0.f, 0.f, 0.f, 0.f}; }
        bf16x8 At[4][2], B0[2][2], B1[2][2];
        const char* ka = (const char*)g.A + (size_t)u.pm * tstep + (size_t)hsel * hstepA; const char* kb = (const char*)g.Bt + (size_t)u.pn * tstep;
        PH_STAGE3(0, ka, kb); PH_STAGE3(3 * HTB, ka + kstepA, kb + kstepB);
        asm volatile("s_waitcnt vmcnt(6)" ::: "memory"); __builtin_amdgcn_s_barrier(); __builtin_amdgcn_sched_barrier(0);
        int cur = 0, nxt2 = 6 * HTB;
        for (int t = 0; t < nt; ++t) {
            const bool more = (t + 2 < nt);
            if (more) PH_STAGE3(nxt2, ka + 2 * kstepA, kb + 2 * kstepB);
            const PG8_LAS unsigned char* sl = lds + cur;
#pragma unroll
            for (int n = 0; n < 2; ++n)
#pragma unroll
                for (int k = 0; k < 2; ++k) { B0[n][k] = *(const PG8_LAS bf16x8*)(sl + boff + n * 2048 + k * 1024); B1[n][k] = *(const PG8_LAS bf16x8*)(sl + HTB + boff + n * 2048 + k * 1024); }
#pragma unroll
            for (int m = 0; m < 4; ++m)
#pragma unroll
                for (int k = 0; k < 2; ++k) At[m][k] = *(const PG8_LAS bf16x8*)(sl + 2 * HTB + aoff + m * 2048 + k * 1024);
            asm volatile("s_waitcnt lgkmcnt(0)" ::: "memory"); __builtin_amdgcn_sched_barrier(0);
            PH_MMA(0, At, B0); PH_MMA(1, At, B1);
            if (more) asm volatile("s_waitcnt vmcnt(6)" ::: "memory"); else asm volatile("s_waitcnt vmcnt(0)" ::: "memory");
            __builtin_amdgcn_s_barrier(); __builtin_amdgcn_sched_barrier(0);
            ka += kstepA; kb += kstepB; cur = (cur == 6 * HTB) ? 0 : cur + 3 * HTB; nxt2 = (nxt2 == 6 * HTB) ? 0 : nxt2 + 3 * HTB;
        }
        E.template run<1>(acc, u, wr, wc, fr, fq, hsel * HALF);
    }
    asm volatile("s_waitcnt lgkmcnt(0)" ::: "memory"); __builtin_amdgcn_s_barrier();
#undef PH_STAGE
#undef PH_STAGE3
#undef PH_MMA
}
}
#ifndef ATT_LOAD_POS
#define ATT_LOAD_POS 0
#endif
#ifndef ATT_WT
#define ATT_WT 0
#endif
#ifndef SCALE_WT
#define SCALE_WT 0
#endif
#ifndef ROWS_PER_TRIP
#define ROWS_PER_TRIP 8
#endif
namespace dattn {
typedef short bf16x8 __attribute__((ext_vector_type(8)));
typedef short s16x4 __attribute__((ext_vector_type(4)));
typedef float f32x16 __attribute__((ext_vector_type(16)));
typedef unsigned u32x4 __attribute__((ext_vector_type(4)));
#define DA_LAS __attribute__((address_space(3)))
constexpr int SEQ = 8192, NH = 12, HD = 64, DA = NH * HD, NKEY = 384, KROW = 144;
constexpr int TB = 192;
constexpr int LDS_K = 0, K_BYTES = NKEY * KROW, LDS_V = K_BYTES, V_HALF = NKEY * 64, LDS_OST = LDS_V + 2 * V_HALF, LDS_ALLB = LDS_OST + 8 * 4096, LDS_NEG = LDS_ALLB + NH * TB * 4, LDS_END = LDS_NEG + 64 * 4;
constexpr int NUNITS = 2 * NH * 32;
__device__ const unsigned char T5_BUCKET[3][132] = {
 {0,1,2,3,4,5,6,7,8,9,10,11,12,13,14,15,16,16,16,16,16,16,17,17,17,17,17,17,17,17,18,18,18,18,18,18,18,18,18,18,19,19,19,19,19,19,19,19,19,19,19,19,19,19,20,20,20,20,20,20,20,20,20,20,20,20,20,20,20,20,20,20,20,21,21,21,21,21,21,21,21,21,21,21,21,21,21,21,21,21,21,21,21,21,21,21,21,21,21,22,22,22,22,22,22,22,22,22,22,22,22,22,22,22,22,22,22,22,22,22,22,22,22,22,22,22,22,22,22,0,0,0},
 {0,4,8,12,16,16,17,17,18,18,19,19,19,19,20,20,20,20,20,21,21,21,21,21,21,22,22,22,22,22,22,22,22,22,23,23,23,23,23,23,23,23,23,23,23,23,24,24,24,24,24,24,24,24,24,24,24,24,24,24,24,24,25,25,25,25,25,25,25,25,25,25,25,25,25,25,25,25,25,25,25,25,25,26,26,26,26,26,26,26,26,26,26,26,26,26,26,26,26,26,26,26,26,26,26,26,26,26,26,26,26,26,26,27,27,27,27,27,27,27,27,27,27,27,27,27,27,27,27,0,0,0},
 {0,16,18,19,20,21,21,22,22,23,23,23,24,24,24,24,25,25,25,25,25,26,26,26,26,26,26,26,26,27,27,27,27,27,27,27,27,27,27,28,28,28,28,28,28,28,28,28,28,28,28,28,29,29,29,29,29,29,29,29,29,29,29,29,29,29,29,29,29,29,30,30,30,30,30,30,30,30,30,30,30,30,30,30,30,30,30,30,30,30,30,30,30,30,30,31,31,31,31,31,31,31,31,31,31,31,31,31,31,31,31,31,31,31,31,31,31,31,31,31,31,31,31,31,31,31,31,31,31,0,0,0}};
__device__ __forceinline__ int crow(int r, int hi) { return (r & 3) + 8 * (r >> 2) + 4 * hi; }
__device__ __forceinline__ unsigned cvtpk(float lo, float hi) { unsigned r; asm volatile("v_cvt_pk_bf16_f32 %0, %1, %2" : "=v"(r) : "v"(lo), "v"(hi)); return r; }
typedef short v4i16_t __attribute__((ext_vector_type(4)));
__device__ __forceinline__ s16x4 vtr(DA_LAS const char* p) { return __builtin_bit_cast(s16x4, __builtin_amdgcn_ds_read_tr16_b64_v4i16((DA_LAS v4i16_t*)p)); }

struct UnitGeom { int b, h, g, dsh, r, I0; };
__device__ __forceinline__ UnitGeom unit_geom(int unit) {
    UnitGeom u; const int bh = unit >> 5, u32i = unit & 31; u.b = bh / NH; u.h = bh % NH; u.g = u.h >> 2; u.dsh = 2 * u.g;
    const int cps = 32 >> u.dsh;
    u.r = u32i / cps; u.I0 = (u32i % cps) * 256; return u;
}
struct UnitRegs { u32x4 kv[6], vv[6]; bf16x8 qr[4]; };
__device__ __forceinline__ void attn_load(int unit, const unsigned short* Q, const unsigned short* K, const unsigned short* V, UnitRegs& R, int tid) {
    const UnitGeom u = unit_geom(unit); const size_t rowbase = (size_t)u.b * SEQ;
    const int lane = tid & 63, q32 = lane & 31, hi = lane >> 5, wid = tid >> 6;
#pragma unroll
    for (int it = 0; it < 6; ++it) { const int idx = tid + 512 * it, row = idx >> 3, ch = idx & 7, J = u.I0 - 128 + row;
        const int Jc = J < 0 ? 0 : J; const size_t ga = (rowbase + (size_t)((Jc << u.dsh) + u.r)) * DA + u.h * HD + ch * 8;
        R.kv[it] = *(const u32x4*)(K + ga); R.vv[it] = *(const u32x4*)(V + ga); }
    const size_t qtok = rowbase + (size_t)(((u.I0 + 32 * wid + q32) << u.dsh) + u.r);
#pragma unroll
    for (int s = 0; s < 4; ++s) R.qr[s] = __builtin_nontemporal_load((const bf16x8*)(Q + qtok * DA + u.h * HD + s * 16 + hi * 8));
}
__device__ __forceinline__ void attn_stage(int unit, const UnitRegs& R, const float* rel_bias, DA_LAS char* lds, int tid) {
    const UnitGeom u = unit_geom(unit);
#pragma unroll
    for (int it = 0; it < 6; ++it) { const int idx = tid + 512 * it, row = idx >> 3, ch = idx & 7; const bool ok = (u.I0 - 128 + row) >= 0; const u32x4 z = (u32x4){0u, 0u, 0u, 0u};
        *(DA_LAS u32x4*)(lds + LDS_K + row * KROW + ch * 16) = ok ? R.kv[it] : z;
        *(DA_LAS u32x4*)(lds + LDS_V + (ch >> 2) * V_HALF + row * 64 + (ch & 3) * 16) = ok ? R.vv[it] : z; }
}
__device__ __forceinline__ void attn_compute(int unit, const bf16x8 (&qr)[4], unsigned short* O, float* lse2, DA_LAS char* lds, int tid) {
    const int lane = tid & 63, q32 = lane & 31, hi = lane >> 5; const int wid = __builtin_amdgcn_readfirstlane(tid >> 6);
    const UnitGeom ug = unit_geom(unit); const int h = ug.h, dsh = ug.dsh, r = ug.r, I0 = ug.I0;
    const size_t rowbase = (size_t)ug.b * SEQ;
    const int Iq = I0 + 32 * wid + q32;
    const size_t qtok = rowbase + (size_t)((Iq << dsh) + r);
    const int Jw = I0 + 32 * wid - 128;
    const DA_LAS float* bias = (const DA_LAS float*)(lds + LDS_ALLB) + h * TB + (q32 - 4 * hi);
    const DA_LAS float* negt = (const DA_LAS float*)(lds + LDS_NEG) + (q32 - 4 * hi);
    f32x16 st[5];
#pragma unroll
    for (int kt = 0; kt < 5; ++kt) { const DA_LAS char* kp = lds + LDS_K + (32 * (wid + kt) + q32) * KROW + hi * 16;
        const bool tile_ok = (Jw + 32 * kt) >= 0;
        const DA_LAS float* bp = tile_ok ? bias + (160 - 32 * kt) : negt + 32;
        f32x16 a;
#pragma unroll
        for (int i = 0; i < 16; ++i) a[i] = bp[-((i & 3) + 8 * (i >> 2))];
#pragma unroll
        for (int s = 0; s < 4; ++s) { const bf16x8 kf = *(const DA_LAS bf16x8*)(kp + s * 32); a = __builtin_amdgcn_mfma_f32_32x32x16_bf16(kf, qr[s], a, 0, 0, 0); }
        st[kt] = a; }
    float mx = -INFINITY;
#pragma unroll
    for (int kt = 0; kt < 5; ++kt)
#pragma unroll
        for (int i = 0; i < 16; ++i) mx = __builtin_fmaxf(mx, st[kt][i]);
    { auto rr = __builtin_amdgcn_permlane32_swap(__float_as_uint(mx), __float_as_uint(mx), false, false); mx = __builtin_fmaxf(__uint_as_float(rr[0]), __uint_as_float(rr[1])); }
    float den = 0.f;
#pragma unroll
    for (int kt = 0; kt < 5; ++kt)
#pragma unroll
        for (int i = 0; i < 16; ++i) { const float p = __builtin_amdgcn_exp2f(st[kt][i] - mx); st[kt][i] = p; den += p; }
    { auto rr = __builtin_amdgcn_permlane32_swap(__float_as_uint(den), __float_as_uint(den), false, false); den = __uint_as_float(rr[0]) + __uint_as_float(rr[1]); }
    f32x16 o[2]; o[0] = f32x16{}; o[1] = f32x16{};
    const DA_LAS char* vp0 = lds + LDS_V + (32 * wid + 4 * hi + ((lane >> 2) & 3)) * 64 + ((lane >> 4) & 1) * 32 + (lane & 3) * 8;
#pragma unroll
    for (int kt = 0; kt < 5; ++kt)
#pragma unroll
        for (int s2 = 0; s2 < 2; ++s2) { u32x4 pw; pw.x = cvtpk(st[kt][8 * s2 + 0], st[kt][8 * s2 + 1]); pw.y = cvtpk(st[kt][8 * s2 + 2], st[kt][8 * s2 + 3]); pw.z = cvtpk(st[kt][8 * s2 + 4], st[kt][8 * s2 + 5]); pw.w = cvtpk(st[kt][8 * s2 + 6], st[kt][8 * s2 + 7]);
            const bf16x8 pa = __builtin_bit_cast(bf16x8, pw);
#pragma unroll
            for (int dh = 0; dh < 2; ++dh) { const DA_LAS char* vp = vp0 + dh * V_HALF + (32 * kt + 16 * s2) * 64;
                const s16x4 lo = vtr(vp), hv = vtr(vp + 8 * 64);
                const bf16x8 vf = (bf16x8){lo[0], lo[1], lo[2], lo[3], hv[0], hv[1], hv[2], hv[3]};
                o[dh] = __builtin_amdgcn_mfma_f32_32x32x16_bf16(vf, pa, o[dh], 0, 0, 0); } }
    const float rl = __builtin_amdgcn_rcpf(den);
    if (hi == 0) lse2[qtok * NH + h] = mx + __builtin_amdgcn_logf(den);
    DA_LAS char* stg = lds + LDS_OST + wid * 4096;
#pragma unroll
    for (int dh = 0; dh < 2; ++dh)
#pragma unroll
        for (int ig = 0; ig < 4; ++ig) { const unsigned long long pk = (unsigned long long)cvtpk(o[dh][4 * ig] * rl, o[dh][4 * ig + 1] * rl) | ((unsigned long long)cvtpk(o[dh][4 * ig + 2] * rl, o[dh][4 * ig + 3] * rl) << 32);
            *(DA_LAS unsigned long long*)(stg + q32 * 128 + (((4 * dh + ig) ^ (q32 & 7)) * 16) + hi * 8) = pk; }
    asm volatile("s_waitcnt lgkmcnt(0)" ::: "memory");
#pragma unroll
    for (int i = 0; i < 4; ++i) { const int row = i * 8 + (lane >> 3), ch = lane & 7; const u32x4 v = *(const DA_LAS u32x4*)(stg + row * 128 + ((ch ^ (row & 7)) * 16));
        const size_t otok = rowbase + (size_t)(((I0 + 32 * wid + row) << dsh) + r);
#if ATT_WT
        asm volatile("global_store_dwordx4 %0, %1, off sc1\n\ts_nop 1" :: "v"(O + otok * DA + h * HD + ch * 8), "v"(v) : "memory"); }
#else
        *(u32x4*)(O + otok * DA + h * HD + ch * 8) = v; }
#endif
}
__device__ __forceinline__ void attn_phase(int u0, int u1, int u2, int count, int reps, const unsigned short* Q, const unsigned short* K, const unsigned short* V, unsigned short* O, float* lse2, const float* rel_bias, DA_LAS char* lds) {
    const int total = count * reps; if (total <= 0) return;
    int tid = threadIdx.x; asm volatile("" : "+v"(tid));
#define DA_UNIT(k_) ((k_) == 0 ? u0 : ((k_) == 1 ? u1 : u2))
    UnitRegs R; attn_load(u0, Q, K, V, R, tid);
    for (int i = tid; i < NH * TB + 64; i += 512) { const int hh_ = i / TB, dist = i - hh_ * TB - 32; const bool ok = (i < NH * TB) && dist >= 0 && dist <= 128; const int dcl = dist < 0 ? 0 : (dist > 128 ? 128 : dist);
        const float bvl = rel_bias[T5_BUCKET[hh_ < NH ? (hh_ >> 2) : 0][dcl] * NH + (hh_ < NH ? hh_ : 0)] * 1.4426950408889634f;
        ((DA_LAS float*)(lds + LDS_ALLB))[i] = ok ? bvl : -INFINITY; }
    for (int i = 0; i < total; ++i) { const int unit = DA_UNIT(i % count);
        asm volatile("" : "+v"(tid));
        attn_stage(unit, R, rel_bias, lds, tid);
#ifdef ATT_SREP
        for (int sr_ = 0; sr_ < ATT_SREP; ++sr_) { asm volatile("" ::: "memory"); attn_stage(unit, R, rel_bias, lds, tid); }
#endif
        bf16x8 qc[4];
#pragma unroll
        for (int s = 0; s < 4; ++s) qc[s] = R.qr[s];
        __syncthreads();
#ifdef ATT_LREP
        for (int lr_ = 0; lr_ < ATT_LREP; ++lr_) { if (i + 1 < total) attn_load(DA_UNIT((i + 1) % count), Q, K, V, R, tid);
#pragma unroll
            for (int z_ = 0; z_ < 6; ++z_) { asm volatile("" : "+v"(R.kv[z_]), "+v"(R.vv[z_])); }
#pragma unroll
            for (int z_ = 0; z_ < 4; ++z_) { asm volatile("" : "+v"(R.qr[z_])); } }
#endif
#ifndef ATT_LOAD_AFTER
        if (i + 1 < total) attn_load(DA_UNIT((i + 1) % count), Q, K, V, R, tid);
#endif
#ifdef ATT_CREP
        for (int cr_ = 0; cr_ < ATT_CREP; ++cr_) { attn_compute(unit, qc, O, lse2, lds, tid); asm volatile("" ::: "memory"); }
#endif
        attn_compute(unit, qc, O, lse2, lds, tid);
#ifdef ATT_LOAD_AFTER
        asm volatile("" ::: "memory"); __builtin_amdgcn_sched_barrier(0);
        if (i + 1 < total) attn_load(DA_UNIT((i + 1) % count), Q, K, V, R, tid);
#endif
        __syncthreads();
    }
}
constexpr int SR = ROWS_PER_TRIP;
__device__ __forceinline__ void scale_rows(unsigned short* O, const float* lse2, int m_lo, int m_hi, int step, int lane) {
    for (int m0 = m_lo; m0 < m_hi; m0 += SR * step) {
        unsigned long long w[SR][3]; float lv[SR][3][3];
#pragma unroll
        for (int rr = 0; rr < SR; ++rr) { const int m = (m0 + rr * step < m_hi) ? m0 + rr * step : m_lo; const float* l = lse2 + (size_t)m * NH;
#pragma unroll
            for (int k = 0; k < 3; ++k) { const int c = lane + 64 * k, hh = (c >> 4) & 3;
                w[rr][k] = *((const unsigned long long*)(O + (size_t)m * DA) + c); lv[rr][k][0] = l[hh]; lv[rr][k][1] = l[4 + hh]; lv[rr][k][2] = l[8 + hh]; } }
#pragma unroll
        for (int rr = 0; rr < SR; ++rr) { const int m = m0 + rr * step; if (m < m_hi) {
#pragma unroll
            for (int k = 0; k < 3; ++k) { const int c = lane + 64 * k, g = c >> 6;
                const float l0 = lv[rr][k][0], l1 = lv[rr][k][1], l2 = lv[rr][k][2]; const float mm = __builtin_fmaxf(__builtin_fmaxf(l0, l1), l2);
                const float e0 = __builtin_amdgcn_exp2f(l0 - mm), e1 = __builtin_amdgcn_exp2f(l1 - mm), e2 = __builtin_amdgcn_exp2f(l2 - mm);
                const float al = (g == 0 ? e0 : (g == 1 ? e1 : e2)) * __builtin_amdgcn_rcpf(e0 + e1 + e2);
                const unsigned w0 = (unsigned)w[rr][k], w1 = (unsigned)(w[rr][k] >> 32);
                const float f0 = __uint_as_float(w0 << 16) * al, f1 = __uint_as_float(w0 & 0xffff0000u) * al, f2 = __uint_as_float(w1 << 16) * al, f3 = __uint_as_float(w1 & 0xffff0000u) * al;
                const unsigned long long pk_ = (unsigned long long)cvtpk(f0, f1) | ((unsigned long long)cvtpk(f2, f3) << 32);
#if SCALE_WT
                asm volatile("global_store_dwordx2 %0, %1, off sc1\n\ts_nop 1" :: "v"((unsigned long long*)(O + (size_t)m * DA) + c), "v"(pk_) : "memory"); } } }
#else
                *((unsigned long long*)(O + (size_t)m * DA) + c) = pk_; } } }
#endif
    }
}
}
#define GAS __attribute__((address_space(1)))
#define LAS __attribute__((address_space(3)))
typedef unsigned short bf16;
typedef unsigned v4u __attribute__((ext_vector_type(4)));
typedef float f32x4 __attribute__((ext_vector_type(4)));
typedef short bf16x8 __attribute__((ext_vector_type(8)));
typedef GAS unsigned gu32;
typedef GAS unsigned long long gu64;
#define RLX_AGENT __ATOMIC_RELAXED, __HIP_MEMORY_SCOPE_AGENT
#define LDS_WAIT() asm volatile("s_waitcnt lgkmcnt(0)" ::: "memory")
#define VM_WAIT() asm volatile("s_waitcnt vmcnt(0)" ::: "memory")
__device__ __forceinline__ unsigned long long rt() { return __builtin_amdgcn_s_memrealtime(); }
__device__ __forceinline__ unsigned f2bf(float f) { unsigned u = __builtin_bit_cast(unsigned, f); return (u + 0x7fffu + ((u >> 16) & 1u)) >> 16; }
__device__ __forceinline__ unsigned pk2(float lo, float hi) { return f2bf(lo) | (f2bf(hi) << 16); }

#ifndef XB_EARLY_INV
#define XB_EARLY_INV 1
#endif
#ifndef XB_DIRECT_RELEASE
#define XB_DIRECT_RELEASE 1
#endif
#define XB_TMO      128
#define XB_XCNT(j)  (256  + 64 * (j))
#define XB_XSUB(j)  (1280 + 64 * (j))
#define XB_XGEN(j)  (2304 + 64 * (j))
#define XB_TOP      3328
#define XB_TOPGEN   3392
#define XCD_BAR_WORDS 3456
#define XB_SPIN_CAP (1u << 18)

__device__ __forceinline__ unsigned xb_ld(unsigned* p)              { return __hip_atomic_load(p, __ATOMIC_RELAXED, __HIP_MEMORY_SCOPE_AGENT); }
__device__ __forceinline__ unsigned xb_add(unsigned* p, unsigned v) { return __hip_atomic_fetch_add(p, v, __ATOMIC_RELAXED, __HIP_MEMORY_SCOPE_AGENT); }
__device__ __forceinline__ unsigned xb_xcc_id() { return (unsigned)__builtin_amdgcn_s_getreg((3 << 11) | 20) & 0xFu; }
#define XB_SPIN(cond, bar) do { unsigned _sp = 0; while (cond) { __builtin_amdgcn_s_sleep(1); \
    if ((++_sp & 255u) == 0u) { if (xb_ld(&(bar)[XB_TMO])) break; if (_sp > XB_SPIN_CAP) { atomicAdd(&(bar)[XB_TMO], 1u); break; } } } } while (0)

struct XcdBarrier {
    unsigned* bar; unsigned x;
    volatile LAS unsigned* st;
};

__device__ __forceinline__ XcdBarrier xcd_barrier_post(unsigned* bar, volatile LAS unsigned* st) {
    XcdBarrier b; b.bar = bar; b.x = xb_xcc_id(); b.st = st;
    if (threadIdx.x == 0) (void)xb_add(&bar[XB_XCNT(b.x)], 1u);
    return b;
}
__device__ __forceinline__ void xcd_barrier_complete(unsigned* bar, unsigned x, unsigned& nloc, unsigned& nx) {
    const unsigned G = gridDim.x * gridDim.y * gridDim.z;
    unsigned sum, cnt, mine, sp = 0u;
    for (;;) {
        sum = 0u; cnt = 0u; mine = 0u;
#pragma unroll
        for (unsigned j = 0; j < 16; ++j) { const unsigned c = xb_ld(&bar[XB_XCNT(j)]); sum += c; cnt += (c > 0u) ? 1u : 0u; mine = (j == x) ? c : mine; }
        if (sum == G) break;
        __builtin_amdgcn_s_sleep(1);
        if ((++sp & 255u) == 0u) { if (xb_ld(&bar[XB_TMO])) break; if (sp > XB_SPIN_CAP) { atomicAdd(&bar[XB_TMO], 1u); break; } }
    }
    nloc = mine > 0u ? mine : 1u; nx = cnt > 0u ? cnt : 1u;
}

__device__ __forceinline__ void xcd_barrier(const XcdBarrier& b) {
    asm volatile("s_waitcnt vmcnt(0)" ::: "memory");
    __syncthreads();
    if (threadIdx.x == 0) {
        unsigned* bar = b.bar;
        __builtin_amdgcn_s_waitcnt(0);
        unsigned nloc = b.st[0], nx = b.st[1];
        if (nloc == 0u) { xcd_barrier_complete(bar, b.x, nloc, nx); b.st[0] = nloc; b.st[1] = nx; }
        const unsigned old = xb_add(&bar[XB_XSUB(b.x)], 1u);
        const unsigned gen = old / nloc;
        if (old + 1u == (gen + 1u) * nloc) {
            __builtin_amdgcn_fence(__ATOMIC_RELEASE, "agent");
            asm volatile("s_waitcnt vmcnt(0)" ::: "memory");
            const unsigned og = xb_add(&bar[XB_TOP], 1u);
            const unsigned tg = og / nx;
#if XB_DIRECT_RELEASE
            if (og + 1u == (tg + 1u) * nx) {
#pragma unroll
                for (unsigned j = 0; j < 16; ++j) (void)xb_add(&bar[XB_XGEN(j)], 1u); }
#if XB_EARLY_INV
            __builtin_amdgcn_fence(__ATOMIC_ACQUIRE, "agent");
            XB_SPIN(xb_ld(&bar[XB_XGEN(b.x)]) == gen, bar);
            asm volatile("s_waitcnt vmcnt(0)" ::: "memory");
#else
            XB_SPIN(xb_ld(&bar[XB_XGEN(b.x)]) == gen, bar);
            __builtin_amdgcn_fence(__ATOMIC_ACQUIRE, "agent");
            asm volatile("s_waitcnt vmcnt(0)" ::: "memory");
#endif
#else
            if (og + 1u == (tg + 1u) * nx) xb_add(&bar[XB_TOPGEN], 1u);
            else XB_SPIN(xb_ld(&bar[XB_TOPGEN]) == tg, bar);
            __builtin_amdgcn_fence(__ATOMIC_ACQUIRE, "agent");
            xb_add(&bar[XB_XGEN(b.x)], 1u);
            asm volatile("s_waitcnt vmcnt(0)" ::: "memory");
#endif
        } else {
#if XB_EARLY_INV
            __builtin_amdgcn_fence(__ATOMIC_ACQUIRE, "agent");
            XB_SPIN(xb_ld(&bar[XB_XGEN(b.x)]) == gen, bar);
            asm volatile("s_waitcnt vmcnt(0)" ::: "memory");
#else
            XB_SPIN(xb_ld(&bar[XB_XGEN(b.x)]) == gen, bar);
            __builtin_amdgcn_fence(__ATOMIC_ACQUIRE, "agent");
            asm volatile("s_waitcnt vmcnt(0)" ::: "memory");
#endif
        }
    }
    __syncthreads();
}
#ifndef HALF_ROUNDS
#define HALF_ROUNDS false
#endif
constexpr int NWAVES = 8;
constexpr int BATCH = 2, SEQ = 8192, DM = 1024, M = BATCH * SEQ, DEPTH = 4, CONVW = 31, DATT = 768, NHEADS = 12, DFF = 2816;
constexpr size_t MiB = 1u << 20;
constexpr size_t WS_CTL = 0, CTL_ZERO_BYTES = 128 * 1024;
constexpr size_t WS_SSQ = 1 * MiB;
constexpr size_t WS_WPW1 = 4 * MiB, WS_WPW2 = 12 * MiB, WS_WQKV = 16 * MiB, WS_WO = 25 * MiB, WS_WGU = 28 * MiB, WS_WDN = 72 * MiB;
constexpr size_t WS_XB = 94 * MiB;
constexpr size_t WS_R = 126 * MiB;
constexpr size_t WS_LSE = 214 * MiB, WS_O = 215 * MiB, WS_END = 239 * MiB;
constexpr int CW_BAR = 4096, CW_SEAM = 16384;
constexpr int RING_BYTES = 131072, LDS_BYTES = HALF_ROUNDS ? 163840 : 147456, MISC_OFF = LDS_BYTES - 256, STATS_OFF = 131072;
static_assert(!HALF_ROUNDS || pg8::HALF_RING_BYTES <= MISC_OFF, "half-unit ring");
static_assert(dattn::LDS_END <= MISC_OFF, "attention LDS map");

template <int CTRL> __device__ __forceinline__ float dpp_quad(float v) { return __builtin_bit_cast(float, __builtin_amdgcn_update_dpp(0, __builtin_bit_cast(int, v), CTRL, 0xF, 0xF, true)); }
__device__ __forceinline__ float wave_sum(float v) {
#pragma unroll
    for (int o = 1; o < 64; o <<= 1) v += __shfl_xor(v, o);
    return v;
}
__device__ __forceinline__ void transpose_item(const float* W, int ldw, int c0, int k0, const float* gain, bf16* WT, int K, int r0, LAS float* scr, int lane) {
    const int kr = lane >> 4, cq = (lane & 15) * 4;
    const float* src = W + (size_t)(k0 + kr) * ldw + c0 + cq;
    f32x4 v[16];
#pragma unroll
    for (int i = 0; i < 16; ++i) v[i] = __builtin_nontemporal_load((const f32x4*)(src + (size_t)(4 * i) * ldw));
    if (gain) {
#pragma unroll
        for (int i = 0; i < 16; ++i) v[i] = v[i] * gain[k0 + 4 * i + kr]; }
#pragma unroll
    for (int i = 0; i < 16; ++i) { LAS float* d = scr + (4 * i + kr) * 65 + cq; d[0] = v[i].x; d[1] = v[i].y; d[2] = v[i].z; d[3] = v[i].w; }
    LDS_WAIT(); asm volatile("" ::: "memory");
    const int c = lane & 7;
#pragma unroll
    for (int j = 0; j < 8; ++j) { const int n = (lane >> 3) + 8 * j; const LAS float* s = scr + (8 * c) * 65 + n;
        v4u o; o.x = pg8::cvt_pk_bf16(s[0 * 65], s[1 * 65]); o.y = pg8::cvt_pk_bf16(s[2 * 65], s[3 * 65]); o.z = pg8::cvt_pk_bf16(s[4 * 65], s[5 * 65]); o.w = pg8::cvt_pk_bf16(s[6 * 65], s[7 * 65]);
        const int rr = r0 + n;
        bf16* dst = TILED_B ? WT + ((size_t)(rr >> 7) * (K >> 6) + (k0 >> 6)) * 8192 + (rr & 127) * 64 + 8 * c : WT + (size_t)rr * K + k0 + 8 * c;
        *(GAS v4u*)dst = o; }
    LDS_WAIT(); asm volatile("" ::: "memory");
}

#ifndef REP_PROL
#define REP_PROL 1
#endif
#ifndef ATT_STAGGER_TICKS
#define ATT_STAGGER_TICKS 0
#endif
#ifndef CONVERT_IN_QKV
#define CONVERT_IN_QKV 1
#endif
#ifndef CONVERT_SPLIT
#define CONVERT_SPLIT 0
#endif
#ifndef REP_CONVERT
#define REP_CONVERT 1
#endif
#ifndef QHALF
#define QHALF 1
#endif
#ifndef GHALF
#define GHALF 0
#endif
#ifndef PROBE_LDA
#define PROBE_LDA 0
#endif
#ifndef PROBE_K
#define PROBE_K 0
#endif
#ifndef PROBE_EPI_MODE
#define PROBE_EPI_MODE 0
#endif
#ifndef REP_PW1
#define REP_PW1 1
#endif
#ifndef REP_CONV
#define REP_CONV 1
#endif
#ifndef REP_QKV
#define REP_QKV 1
#endif
#ifndef REP_ATT
#define REP_ATT 1
#endif
#ifndef REP_BAR
#define REP_BAR 1
#endif
#ifndef PROBE_RESID
#define PROBE_RESID 0
#endif
#ifndef SPREAD_CONVERT
#define SPREAD_CONVERT 1
#endif
#ifndef GU_ALIGN
#define GU_ALIGN true
#endif
#ifndef GU_SP2
#define GU_SP2 true
#endif
#ifndef REP_PROL_W
#define REP_PROL_W 1
#endif
#ifndef REP_PROL_X
#define REP_PROL_X 1
#endif
#ifndef FUSE_FINAL
#define FUSE_FINAL 0
#endif
#ifndef TILED_H
#define TILED_H false
#endif
#ifndef RESID_ALIGN
#define RESID_ALIGN true
#endif
#ifndef ATT_LOCAL
#define ATT_LOCAL 0
#endif
#ifndef LAST_STAGGER_TICKS
#define LAST_STAGGER_TICKS 0
#endif
#ifndef CONVERT_FIRST
#define CONVERT_FIRST 1
#endif
#ifndef REP_GU
#define REP_GU 1
#endif
struct Args { const float* in[18]; float* out; unsigned char* ws; int ph_lo, ph_hi; };

__device__ __forceinline__ void convert_layer_weights(const Args& a, int layer, LAS unsigned char* lds, int w, int nw, int wave, int lane) {
    LAS float* scr = (LAS float*)(lds + wave * 16640);
    unsigned char* ws = a.ws; const int j = layer >> 1;
    const float* norm_mix = a.in[1] + layer * DM; const float* norm_ffn = a.in[2] + layer * DM;
    constexpr int I_PW1 = 16 * 32, I_PW2 = 16 * 16, I_QKV = 16 * 36, I_WO = 12 * 16, I_GU = 16 * 88, I_DN = 44 * 16, I_MIX = I_PW1 + I_PW2;
    static_assert(I_QKV + I_WO == I_MIX, "items per mixer");
    for (int it = w; it < I_MIX + I_GU + I_DN; it += nw) {
        int r = it;
        if (r < I_MIX) {
            if ((layer & 1) == 0) {
                if (r < I_PW1) { const int kb = r >> 5, nb = r & 31, n0 = nb * 64; const int src = ((n0 >> 7) & 1) * 1024 + (n0 >> 8) * 128 + (n0 & 127);
                    transpose_item(a.in[4] + (size_t)j * 1024 * 2048, 2048, src, kb * 64, norm_mix, (bf16*)(ws + WS_WPW1) + (size_t)j * 2048 * 1024, 1024, n0, scr, lane); }
                else { r -= I_PW1; const int kb = r >> 4, nb = r & 15;
                    transpose_item(a.in[10] + (size_t)j * 1024 * 1024, 1024, nb * 64, kb * 64, nullptr, (bf16*)(ws + WS_WPW2) + (size_t)j * 1024 * 1024, 1024, nb * 64, scr, lane); }
            } else {
                if (r < I_QKV) { const int kb = r / 36, nb = r % 36;
                    transpose_item(a.in[12] + (size_t)j * 1024 * 2304, 2304, nb * 64, kb * 64, norm_mix, (bf16*)(ws + WS_WQKV) + (size_t)j * 2304 * 1024, 1024, nb * 64, scr, lane); }
                else { r -= I_QKV; const int kb = r >> 4, nb = r & 15;
                    transpose_item(a.in[13] + (size_t)j * 768 * 1024, 1024, nb * 64, kb * 64, nullptr, (bf16*)(ws + WS_WO) + (size_t)j * 1024 * 768, 768, nb * 64, scr, lane); }
            }
            continue; }
        r -= I_MIX;
        if (r < I_GU) { const int kb = r / 88, nb = r % 88, n0 = nb * 64;
            const float* W = ((n0 >> 7) & 1) ? a.in[16] : a.in[15]; const int src = (n0 >> 8) * 128 + (n0 & 127);
            transpose_item(W + (size_t)layer * 1024 * DFF, DFF, src, kb * 64, norm_ffn, (bf16*)(ws + WS_WGU) + (size_t)layer * 5632 * 1024, 1024, n0, scr, lane); continue; }
        r -= I_GU;
        { const int kb = r >> 4, nb = r & 15;
            transpose_item(a.in[17] + (size_t)layer * DFF * 1024, 1024, nb * 64, kb * 64, nullptr, (bf16*)(ws + WS_WDN) + (size_t)layer * 1024 * DFF, DFF, nb * 64, scr, lane); }
    }
}
__device__ __forceinline__ void prologue(const Args& a, LAS unsigned char* lds, int gw, int ngw, int wave, int lane) {
    unsigned char* ws = a.ws;
    for (int rw = 0; rw < REP_PROL_W; ++rw) convert_layer_weights(a, 0, lds, gw, ngw, wave, lane);
#if !SPREAD_CONVERT
    for (int l = 1; l < DEPTH; ++l) convert_layer_weights(a, l, lds, gw, ngw, wave, lane);
#endif
    const float* x = a.in[0]; bf16* XB = (bf16*)(ws + WS_XB); pg8::ssq_t* ssq0 = (pg8::ssq_t*)(ws + WS_SSQ);
    const int nwgs = ngw / NWAVES, vblk = gw / NWAVES, rpw = (M + nwgs - 1) / nwgs, row_lo = vblk * rpw, row_hi = (row_lo + rpw < M) ? row_lo + rpw : M;
    { v4u* z = (v4u*)(ssq0 + M);
      for (int i = gw * 64 + lane; i < 8 * M * 8 / 16; i += ngw * 64) z[i] = (v4u){0u, 0u, 0u, 0u}; }
    for (int rx = 0; rx < REP_PROL_X; ++rx)
    for (int m0 = row_lo + (gw % NWAVES) * 4; m0 < row_hi; m0 += NWAVES * 4) {
        f32x4 v[4][4];
#pragma unroll
        for (int rr = 0; rr < 4; ++rr) { const GAS f32x4* xr = (const GAS f32x4*)(x + (size_t)(m0 + rr) * DM) + lane;
#pragma unroll
            for (int j = 0; j < 4; ++j) v[rr][j] = __builtin_nontemporal_load(xr + 64 * j); }
        float s[4];
#pragma unroll
        for (int rr = 0; rr < 4; ++rr) { s[rr] = 0.f;
#pragma unroll
            for (int j = 0; j < 4; ++j) s[rr] += (v[rr][j].x * v[rr][j].x + v[rr][j].y * v[rr][j].y) + (v[rr][j].z * v[rr][j].z + v[rr][j].w * v[rr][j].w); }
#pragma unroll
        for (int o = 1; o < 64; o <<= 1) {
#pragma unroll
            for (int rr = 0; rr < 4; ++rr) s[rr] += __shfl_xor(s[rr], o); }
#pragma unroll
        for (int rr = 0; rr < 4; ++rr) { GAS unsigned long long* o8 = (GAS unsigned long long*)(XB + (size_t)(m0 + rr) * DM) + lane;
#pragma unroll
            for (int j = 0; j < 4; ++j) o8[64 * j] = (unsigned long long)pg8::cvt_pk_bf16(v[rr][j].x, v[rr][j].y) | ((unsigned long long)pg8::cvt_pk_bf16(v[rr][j].z, v[rr][j].w) << 32);
            if (lane == 0) ssq0[m0 + rr] = pg8::ssq_enc(s[rr]); }
    }
}

typedef float f32x2 __attribute__((ext_vector_type(2)));
#ifndef CONV_WT
#define CONV_WT 0
#endif
constexpr int CONV_TT = 64, CONV_ROWS = CONV_TT + 30, CONV_RING = 16;
#define CONV_LOAD(R) (*(const GAS unsigned*)(ubase + (size_t)(((R) < 30 && tb - 30 + (R) < 0) ? 30 - tb : (R)) * (DM * 2)))
#define CONV_ROW(R) { unsigned xw_ = xq[(R) % CONV_RING]; if ((R) < 30 && tb - 30 + (R) < 0) xw_ = 0u; \
    if ((R) + CONV_RING < CONV_ROWS) xq[(R) % CONV_RING] = CONV_LOAD((R) + CONV_RING);     \
    f32x2 xv_; xv_.x = __uint_as_float(xw_ << 16); xv_.y = __uint_as_float(xw_ & 0xffff0000u); \
    _Pragma("unroll") for (int t = ((R) > 30 ? (R) - 30 : 0); t <= ((R) < CONV_TT ? (R) : CONV_TT - 1); ++t) a[t] += w[(R) - t] * xv_; \
    __builtin_amdgcn_sched_barrier(0); }
#define CONV_ROW2(B) CONV_ROW((B)) CONV_ROW((B) + 1)
#define CONV_ROW8(B) CONV_ROW2((B)) CONV_ROW2((B) + 2) CONV_ROW2((B) + 4) CONV_ROW2((B) + 6)
#define CONV_ROW32(B) CONV_ROW8((B)) CONV_ROW8((B) + 8) CONV_ROW8((B) + 16) CONV_ROW8((B) + 24)
__device__ __forceinline__ void conv_phase(const bf16* U, const float* wdw, const float* bdw, const float* lng, const float* lnb, bf16* C, LAS unsigned char* lds, int vcu, int G, int tid_) {
    f32x2 w[CONVW];
    { const int c0 = 2 * tid_;
#pragma unroll
      for (int k = 0; k < CONVW; ++k) w[k] = *(const f32x2*)(wdw + k * DM + c0); }
    constexpr int NT = M / CONV_TT; const int tpw = (NT + G - 1) / G;
    for (int ti = 0; ti < tpw * REP_CONV; ++ti) { const int tile = vcu * tpw + (ti % tpw); if (tile >= NT) break;
        int tid = tid_; asm volatile("" : "+v"(tid));
        const int c0 = 2 * tid, lane = tid & 63, wave = __builtin_amdgcn_readfirstlane(tid >> 6);
        const int m0 = tile * CONV_TT, tb = m0 & (SEQ - 1);
        const char* ubase = (const char*)U + ((ptrdiff_t)(m0 - 30) * DM + c0) * 2;
        const f32x2 bd = *(const f32x2*)(bdw + c0);
        __builtin_amdgcn_sched_barrier(0);
        unsigned xq[CONV_RING];
#pragma unroll
        for (int r = 0; r < CONV_RING; ++r) xq[r] = CONV_LOAD(r);
        __builtin_amdgcn_sched_barrier(0);
        f32x2 a[CONV_TT];
#pragma unroll
        for (int t = 0; t < CONV_TT; ++t) a[t] = bd;
        __builtin_amdgcn_sched_barrier(0);
        CONV_ROW32(0) CONV_ROW32(32) CONV_ROW8(64) CONV_ROW8(72) CONV_ROW8(80) CONV_ROW2(88) CONV_ROW2(90) CONV_ROW2(92)
#pragma unroll
        for (int t = 0; t < CONV_TT; ++t) asm volatile("" : "+v"(a[t]));
        LAS float* P = (LAS float*)lds + (tid >> 2); LAS float* stats = (LAS float*)(lds + 65536);
#pragma unroll
        for (int t = 0; t < CONV_TT; ++t) { float s1 = a[t].x + a[t].y, s2 = a[t].x * a[t].x + a[t].y * a[t].y;
            s1 += dpp_quad<0xB1>(s1); s2 += dpp_quad<0xB1>(s2); s1 += dpp_quad<0x4E>(s1); s2 += dpp_quad<0x4E>(s2);
            if ((tid & 3) == 0) { P[(2 * t) * 128] = s1; P[(2 * t + 1) * 128] = s2; } }
        __syncthreads();
        { const LAS float* Pr = (const LAS float*)lds + wave * 16 * 128 + lane;
          float sv[16];
#pragma unroll
          for (int j = 0; j < 16; ++j) sv[j] = Pr[j * 128] + Pr[j * 128 + 64];
#pragma unroll
          for (int o = 1; o < 64; o <<= 1) {
#pragma unroll
              for (int j = 0; j < 16; ++j) sv[j] += __shfl_xor(sv[j], o); }
          if (lane == 0) {
#pragma unroll
              for (int j = 0; j < 16; j += 2) { const float mean = sv[j] * (1.0f / DM), var = sv[j + 1] * (1.0f / DM) - mean * mean;
                  stats[wave * 16 + j] = mean; stats[wave * 16 + j + 1] = __builtin_amdgcn_rsqf(var + 1e-6f); } } }
        __syncthreads();
        const f32x2 g2 = *(const f32x2*)(lng + c0), b2 = *(const f32x2*)(lnb + c0);
        unsigned* crow = (unsigned*)((char*)C + (size_t)((unsigned)m0 * (DM * 2) + (unsigned)c0 * 2));
#pragma unroll
        for (int t = 0; t < CONV_TT; ++t) { const f32x2 mr = *(const LAS f32x2*)(stats + 2 * t);
            const f32x2 y = (a[t] - mr.x) * (g2 * mr.y) + b2;
            f32x2 e = y * (-1.4426950408889634f); e.x = __builtin_amdgcn_exp2f(e.x); e.y = __builtin_amdgcn_exp2f(e.y); e = e + 1.0f;
            const unsigned cw_ = pg8::cvt_pk_bf16(y.x * __builtin_amdgcn_rcpf(e.x), y.y * __builtin_amdgcn_rcpf(e.y));
#if CONV_WT
            asm volatile("global_store_dword %0, %1, off sc1" :: "v"(crow + t * (DM / 2)), "v"(cw_) : "memory"); }
#else
            crow[t * (DM / 2)] = cw_; }
#endif
        __syncthreads();
    }
}
#undef CONV_ROW32
#undef CONV_ROW8
#undef CONV_ROW2
#undef CONV_ROW
#undef CONV_LOAD

__global__ void __launch_bounds__(NWAVES * 64, 2) trunk_fwd(Args args) {
    extern __shared__ __attribute__((aligned(16))) unsigned char lds[];
    LAS unsigned char* L = (LAS unsigned char*)lds;
    volatile LAS unsigned* MISC = (volatile LAS unsigned*)(L + MISC_OFF);
    const int tid0 = threadIdx.x, wave = __builtin_amdgcn_readfirstlane(tid0 >> 6);
    const int G = gridDim.x, bx = blockIdx.x, vcu = (G % 8 == 0) ? (bx % 8) * (G / 8) + bx / 8 : bx;
    unsigned char* ws = args.ws;
    gu32* ctl = (gu32*)(ws + WS_CTL);
    if (tid0 < 64) MISC[tid0] = 0u;
    __syncthreads();
    XcdBarrier bar = xcd_barrier_post((unsigned*)(ctl + CW_BAR), MISC + 8);
    const int lo = args.ph_lo, hi = args.ph_hi; int pid = 0;
#define PH_BEGIN if (pid >= lo && pid < hi) { int tid = tid0; asm volatile("" : "+v"(tid)); const int lane = tid & 63; (void)lane;
#define PH_END   if (pid + 1 < hi) { for (int rb = 0; rb < REP_BAR; ++rb) xcd_barrier(bar); } } ++pid;
    bf16* XB = (bf16*)(ws + WS_XB); pg8::ssq_t* SSQ = (pg8::ssq_t*)(ws + WS_SSQ);
    bf16* R0 = (bf16*)(ws + WS_R);
    const int gw = vcu * NWAVES + wave, ngw = G * NWAVES;

    PH_BEGIN for (int rep = 0; rep < REP_PROL; ++rep) prologue(args, L, gw, ngw, wave, lane); PH_END

    for (int layer = 0; layer < DEPTH; ++layer) {
        const int j = layer >> 1;
        if ((layer & 1) == 0) {
            bf16* U = R0; bf16* C = R0 + (size_t)M * DM;
            PH_BEGIN
                pg8::Gemm g{XB, (const bf16*)(ws + WS_WPW1) + (size_t)j * 2048 * 1024, M, 2048, 1024, false}; pg8::StaticOrder S; S.init(M, 2048, G, bx);
                pg8::EpiGate<0> E{U, DM, SSQ + (size_t)layer * M, args.in[5] + j * 2048, false};
                for (int rep = 0; rep < REP_PW1; ++rep) { pg8::EpiGate<0> E2 = E; E2.probe = (rep + 1 < REP_PW1) ? PROBE_EPI_MODE : 0; pg8::Gemm g2 = g; if (PROBE_K > 0 && rep + 1 < REP_PW1) g2.K = PROBE_K; if (PROBE_LDA > 0 && rep + 1 < REP_PW1) g2.lda = PROBE_LDA; pg8::gemm_phase<pg8::EpiGate<0>, pg8::StaticOrder, true, true>(L, g2, S, E2); }
            PH_END
            PH_BEGIN
                conv_phase(U, args.in[6] + (size_t)j * CONVW * DM, args.in[7] + j * DM, args.in[8] + j * DM, args.in[9] + j * DM, C, L, vcu, G, tid);
            PH_END
            PH_BEGIN
                pg8::Gemm g{C, (const bf16*)(ws + WS_WPW2) + (size_t)j * 1024 * 1024, M, 1024, 1024, false}; pg8::StaticOrder S; S.init(M, 1024, G, bx);
                if (PROBE_RESID & 1) { pg8::EpiResid<false, true> E{nullptr, XB, U, DM, args.in[11] + j * DM, SSQ + (size_t)12 * M};
                    pg8::gemm_phase<pg8::EpiResid<false, true>, pg8::StaticOrder, RESID_ALIGN, true>(L, g, S, E); }
                if (layer == 0) { pg8::EpiResid<true, true> E{args.in[0], XB, XB, DM, args.in[11] + j * DM, SSQ + (size_t)(4 + layer) * M};
                    pg8::gemm_phase<pg8::EpiResid<true, true>, pg8::StaticOrder, RESID_ALIGN, true>(L, g, S, E); }
                else { pg8::EpiResid<false, true> E{nullptr, XB, XB, DM, args.in[11] + j * DM, SSQ + (size_t)(4 + layer) * M};
                    pg8::gemm_phase<pg8::EpiResid<false, true>, pg8::StaticOrder, RESID_ALIGN, true>(L, g, S, E); }
            PH_END
        } else {
            bf16* Qb = R0; bf16* Kb = R0 + (size_t)M * DATT; bf16* Vb = R0 + 2 * (size_t)M * DATT; float* LSE = (float*)(ws + WS_LSE); bf16* Ob = (bf16*)(ws + WS_O);
            PH_BEGIN
                const bool qhalf = HALF_ROUNDS && QHALF;
                pg8::Gemm g{XB, (const bf16*)(ws + WS_WQKV) + (size_t)j * 2304 * 1024, M, 2304, 1024, false}; pg8::StaticOrder S; S.init(M, 2304, G, bx, qhalf);
                pg8::EpiQkv E{Qb, DATT, SSQ + (size_t)layer * M, DATT, (size_t)M * DATT, 0.125f * 1.4426950408889634f};
#if SPREAD_CONVERT && CONVERT_IN_QKV
                if (layer + 1 < DEPTH && !qhalf) {
                    const int rem = S.nwg % G, nidle = G - rem;
                    if (rem != 0 && bx >= rem) { convert_layer_weights(args, layer + 1, L, (bx - rem) * NWAVES + wave, nidle * NWAVES, wave, lane); __syncthreads(); } }
#endif
                for (int rep = 0; rep < REP_QKV; ++rep) { pg8::gemm_phase<pg8::EpiQkv, pg8::StaticOrder, true, true>(L, g, S, E); if (qhalf) pg8::gemm_half_phase<pg8::EpiQkv>(L, g, S, E); }
#if SPREAD_CONVERT
                if (false) {
                    const int rem = S.nwg % G, nidle = G - rem;
                    if (bx >= rem) convert_layer_weights(args, layer + 1, L, (bx - rem) * NWAVES + wave, nidle * NWAVES, wave, lane); }
#endif
            PH_END
            PH_BEGIN
                if (ATT_LOCAL && G == 256) {
                    const int x = bx & 7, w = bx >> 3, b = x >> 2, xq = x & 3; int ul[3];
#pragma unroll
                    for (int i = 0; i < 3; ++i) { const int lid = 3 * w + i; int h, u32i;
                        if (lid < 32) { h = lid >> 3; u32i = 8 * xq + (lid & 7); }
                        else if (lid < 64) { const int l = lid - 32, rem = l & 7; h = 4 + (l >> 3); u32i = (rem >> 1) * 8 + 2 * xq + (rem & 1); }
                        else { const int l = lid - 64; h = 8 + (l >> 3); u32i = (8 * (xq & 1) + (l & 7)) * 2 + (xq >> 1); }
                        ul[i] = (b * 12 + h) * 32 + u32i; }
                    dattn::attn_phase(ul[0], ul[1], ul[2], 3, REP_ATT, Qb, Kb, Vb, Ob, LSE, args.in[14], (LAS char*)L);
                } else {
                if (ATT_STAGGER_TICKS > 0 && ((bx >> 3) & 1)) {
                    const unsigned long long t0 = __builtin_amdgcn_s_memrealtime(); while (__builtin_amdgcn_s_memrealtime() - t0 < (unsigned long long)ATT_STAGGER_TICKS) __builtin_amdgcn_s_sleep(4); }
                const int upw = (dattn::NUNITS + G - 1) / G, first = vcu * upw, cnt = (first + upw <= dattn::NUNITS) ? upw : (dattn::NUNITS - first);
                for (int i0 = 0; i0 < cnt; i0 += 3) dattn::attn_phase(first + i0, first + i0 + 1, first + i0 + 2, (cnt - i0 < 3) ? cnt - i0 : 3, REP_ATT, Qb, Kb, Vb, Ob, LSE, args.in[14], (LAS char*)L); }
            PH_END
            PH_BEGIN
                { const int rpw = (M + G - 1) / G, row_lo = vcu * rpw, row_hi = (row_lo + rpw < M) ? row_lo + rpw : M; dattn::scale_rows(Ob, LSE, row_lo + wave, row_hi, NWAVES, lane); }
            PH_END
            PH_BEGIN
                pg8::Gemm g{Ob, (const bf16*)(ws + WS_WO) + (size_t)j * 1024 * 768, M, 1024, 768, false}; pg8::StaticOrder S; S.init(M, 1024, G, bx);
                if (PROBE_RESID & 2) { pg8::EpiResid<false, false> E{nullptr, XB, Qb, DM, nullptr, SSQ + (size_t)12 * M};
                    pg8::gemm_phase<pg8::EpiResid<false, false>, pg8::StaticOrder, RESID_ALIGN, true>(L, g, S, E); }
                pg8::EpiResid<false, false> E{nullptr, XB, XB, DM, nullptr, SSQ + (size_t)(4 + layer) * M};
                pg8::gemm_phase<pg8::EpiResid<false, false>, pg8::StaticOrder, RESID_ALIGN, true>(L, g, S, E);
            PH_END
        }
        bf16* H = R0;
        PH_BEGIN
            const bool ghalf = HALF_ROUNDS && GHALF && (layer + 1 >= DEPTH);
            pg8::Gemm g{XB, (const bf16*)(ws + WS_WGU) + (size_t)layer * 5632 * 1024, M, 5632, 1024, false}; pg8::StaticOrder S; S.init(M, 5632, G, bx, ghalf);
            pg8::EpiGate<1> E{H, DFF, SSQ + (size_t)(4 + layer) * M, nullptr, TILED_H};
#if SPREAD_CONVERT && CONVERT_FIRST
            if (layer + 1 < DEPTH && !ghalf && !(CONVERT_IN_QKV && (layer & 1))) { const int rem = S.nwg % G, nidle = G - rem;
                if (bx >= rem) { for (int rc_ = 0; rc_ < REP_CONVERT; ++rc_) {
                    if (CONVERT_SPLIT) convert_layer_weights(args, layer + 1, L, (bx - rem) * NWAVES + wave, 2 * nidle * NWAVES, wave, lane);
                    else convert_layer_weights(args, layer + 1, L, (bx - rem) * NWAVES + wave, nidle * NWAVES, wave, lane);
                    __syncthreads(); } } }
            if (LAST_STAGGER_TICKS > 0 && layer + 1 >= DEPTH && !ghalf) { const int rem = S.nwg % G;
                if (rem != 0 && bx >= rem) { const unsigned long long t0 = __builtin_amdgcn_s_memrealtime(); while (__builtin_amdgcn_s_memrealtime() - t0 < (unsigned long long)LAST_STAGGER_TICKS) __builtin_amdgcn_s_sleep(8); } }
#endif
            for (int rep = 0; rep < REP_GU; ++rep) { pg8::gemm_phase<pg8::EpiGate<1>, pg8::StaticOrder, GU_ALIGN, GU_SP2>(L, g, S, E); if (ghalf) pg8::gemm_half_phase<pg8::EpiGate<1>>(L, g, S, E); }
#if SPREAD_CONVERT && CONVERT_FIRST
            if (CONVERT_SPLIT && layer + 1 < DEPTH && !ghalf) { const int rem = S.nwg % G, nidle = G - rem;
                if (bx >= rem) convert_layer_weights(args, layer + 1, L, (bx - rem) * NWAVES + wave + nidle * NWAVES, 2 * nidle * NWAVES, wave, lane); }
#endif
#if SPREAD_CONVERT && !CONVERT_FIRST
            if (layer + 1 < DEPTH && !ghalf) {
                const int rem = S.nwg % G, nidle = G - rem;
                if (bx >= rem) convert_layer_weights(args, layer + 1, L, (bx - rem) * NWAVES + wave, nidle * NWAVES, wave, lane); }
#endif
        PH_END
        PH_BEGIN
            pg8::Gemm g{H, (const bf16*)(ws + WS_WDN) + (size_t)layer * 1024 * DFF, M, 1024, DFF, TILED_H}; pg8::StaticOrder S; S.init(M, 1024, G, bx);
            if (PROBE_RESID & 4) { pg8::EpiResid<false, false> E{nullptr, XB, (bf16*)(ws + WS_LSE), DM, nullptr, SSQ + (size_t)12 * M};
                pg8::gemm_phase<pg8::EpiResid<false, false>, pg8::StaticOrder, RESID_ALIGN, true>(L, g, S, E); }
            if (FUSE_FINAL && layer == DEPTH - 1 && G >= (M / 256) * 4) {
                pg8::EpiFinal E{XB, args.out, DM, args.in[3], SSQ + (size_t)8 * M, (unsigned*)(ctl + CW_SEAM), (LAS unsigned*)(L + MISC_OFF + 64), 32u};
                pg8::gemm_phase<pg8::EpiFinal, pg8::StaticOrder, true, true>(L, g, S, E); }
            else {
            pg8::EpiResid<false, false> E{nullptr, XB, XB, DM, nullptr, SSQ + (size_t)(layer == DEPTH - 1 ? 8 : layer + 1) * M};
            pg8::gemm_phase<pg8::EpiResid<false, false>, pg8::StaticOrder, RESID_ALIGN, true>(L, g, S, E); }
        PH_END
    }
    PH_BEGIN
        const float* fn = args.in[3]; const pg8::ssq_t* ssq = SSQ + (size_t)8 * M; float* out = args.out;
        const int rpw = (M + G - 1) / G, row_lo = vcu * rpw, row_hi = (row_lo + rpw < M) ? row_lo + rpw : M;
        for (int m0 = row_lo + wave; m0 < row_hi; m0 += ROWS_PER_TRIP * NWAVES) {
            unsigned long long wv[ROWS_PER_TRIP][4]; float rsv[ROWS_PER_TRIP];
#pragma unroll
            for (int rr = 0; rr < ROWS_PER_TRIP; ++rr) { const int m = (m0 + rr * NWAVES < row_hi) ? m0 + rr * NWAVES : row_lo; rsv[rr] = pg8::rstd_of(ssq + m);
                const GAS unsigned long long* xr = (const GAS unsigned long long*)(XB + (size_t)m * DM) + lane;
#pragma unroll
                for (int q = 0; q < 4; ++q) wv[rr][q] = __builtin_nontemporal_load(xr + 64 * q); }
#pragma unroll
            for (int rr = 0; rr < ROWS_PER_TRIP; ++rr) { const int m = m0 + rr * NWAVES; if (m < row_hi) { GAS f32x4* orow = (GAS f32x4*)(out + (size_t)m * DM) + lane;
#pragma unroll
                for (int q = 0; q < 4; ++q) { const unsigned w0 = (unsigned)wv[rr][q], w1 = (unsigned)(wv[rr][q] >> 32); const f32x4 gq = *((const f32x4*)fn + lane + 64 * q);
                    const f32x4 v = (f32x4){__uint_as_float(w0 << 16), __uint_as_float(w0 & 0xffff0000u), __uint_as_float(w1 << 16), __uint_as_float(w1 & 0xffff0000u)};
                    __builtin_nontemporal_store(v * rsv[rr] * gq, orow + 64 * q); } } } }
    PH_END
#undef PH_BEGIN
#undef PH_END
}

constexpr int N_PHASES = 1 + 2 * 5 + 2 * 6 + 1;
#ifndef MK_PER_PHASE
#define MK_PER_PHASE 0
#endif
extern "C" void kernel_launch(void* const* d_in, const int* in_sizes, int n_in, void* d_out, int out_size, void* d_ws, size_t ws_size, hipStream_t stream) {
    static int grid = 0;
    if (grid == 0) {
        if (n_in != 18 || in_sizes[0] != M * DM || out_size != M * DM || ws_size < WS_END) { fprintf(stderr, "kernel_launch: unexpected shapes (n_in %d, in0 %d, out %d, ws %zu); nothing launched\n", n_in, n_in > 0 ? in_sizes[0] : -1, out_size, ws_size); grid = -1; return; }
        int dev = 0, cus = 0, per_cu = 0;
        if (hipGetDevice(&dev) != hipSuccess || hipDeviceGetAttribute(&cus, hipDeviceAttributeMultiprocessorCount, dev) != hipSuccess) { grid = -1; return; }
        if (hipFuncSetAttribute((const void*)trunk_fwd, hipFuncAttributeMaxDynamicSharedMemorySize, LDS_BYTES) != hipSuccess) { fprintf(stderr, "kernel_launch: hipFuncSetAttribute failed\n"); grid = -1; return; }
        if (hipOccupancyMaxActiveBlocksPerMultiprocessor(&per_cu, (const void*)trunk_fwd, NWAVES * 64, LDS_BYTES) != hipSuccess || per_cu < 1) { fprintf(stderr, "kernel_launch: occupancy query says %d blocks per CU\n", per_cu); }
        (void)hipGetLastError();
        grid = cus;
    }
    if (grid < 0) return;
    (void)hipMemsetAsync((char*)d_ws + WS_CTL, 0, CTL_ZERO_BYTES, stream);
    Args a{};
    for (int i = 0; i < 18; ++i) a.in[i] = (const float*)d_in[i];
    a.out = (float*)d_out; a.ws = (unsigned char*)d_ws;
#if MK_PER_PHASE
    for (int p = 0; p < N_PHASES; ++p) { a.ph_lo = p; a.ph_hi = p + 1; hipLaunchKernelGGL(trunk_fwd, dim3(grid), dim3(NWAVES * 64), LDS_BYTES, stream, a); }
#else
    a.ph_lo = 0; a.ph_hi = N_PHASES - ((FUSE_FINAL && grid >= (M / 256) * 4) ? 1 : 0); hipLaunchKernelGGL(trunk_fwd, dim3(grid), dim3(NWAVES * 64), LDS_BYTES, stream, a);
#endif
}
```

```cpp
#include <hip/hip_runtime.h>
#include <cstdio>
#include <cstdint>
#include <cmath>
#ifndef PG8_WGM
#define PG8_WGM 8
#endif
namespace pg8 {
#define PG8_LAS __attribute__((address_space(3)))
typedef unsigned short bf16_t;
typedef short bf16x8 __attribute__((ext_vector_type(8)));
typedef float f32x4 __attribute__((ext_vector_type(4)));
typedef unsigned u32x4 __attribute__((ext_vector_type(4)));
constexpr int BM = 256, BK = 64, HALF = 128, HTB = HALF * BK * 2  , STAGE_BYTES = 8 * HTB, NXCD = 8, WGM = PG8_WGM;

__host__ __device__ __forceinline__ int lds_byte(int r, int c) { const int st = (r >> 4) * 2 + (c >> 5), rr = r & 15, cc = c & 31, ob = rr * 64 + cc * 2; return st * 1024 + (ob ^ (((ob >> 9) & 1) << 5)); }
__host__ __device__ __forceinline__ void stage_rc(int b, int& R, int& C) { const int st = b / 1024, sb = b % 1024, swz = sb ^ (((sb >> 9) & 1) << 5); R = (st >> 1) * 16 + swz / 64; C = (st & 1) * 32 + (swz % 64) / 2; }
__host__ __device__ __forceinline__ int perm32(int rho) { const int n = rho >> 4, i = rho & 15; return 8 * (i >> 2) + 4 * n + (i & 3); }

struct Unit { int pm, pn; };
struct Gemm { const bf16_t* A; const bf16_t* Bt; int M, N, K; bool tiledA; int lda = 0; };
__host__ __device__ __forceinline__ size_t tiled_off(int row, int col, int K) { return ((size_t)(row >> 7) * (K >> 6) + (col >> 6)) * 8192 + (size_t)((row & 127) * 64 + (col & 63)); }

struct StaticOrder {
    int nM, nN, nwg, G, c, lim;
    __host__ __device__ void init(int M, int N, int G_, int c_, bool whole_rounds_only = false) { nM = M / BM; nN = N / BM; nwg = nM * nN; G = G_; c = c_; lim = whole_rounds_only ? (nwg / G) * G : nwg; }
    __host__ __device__ bool unit_at(long L, Unit& u) const {
        int wgid = (int)L; { const int q = nwg / NXCD, r = nwg % NXCD, xcd = wgid % NXCD, off = wgid / NXCD; wgid = (xcd < r ? xcd * (q + 1) : r * (q + 1) + (xcd - r) * q) + off; }
        const int nig = WGM * nN, gid = wgid / nig, fm = gid * WGM, gsz = (nM - fm) < WGM ? (nM - fm) : WGM;
        u.pm = fm + ((wgid % nig) % gsz); u.pn = (wgid % nig) / gsz; return true;
    }
    __host__ __device__ bool next(int i, Unit& u) const {
        const long L = (long)i * G + c; if (L >= lim) return false;
        int wgid = (int)L; { const int q = nwg / NXCD, r = nwg % NXCD, xcd = wgid % NXCD, off = wgid / NXCD; wgid = (xcd < r ? xcd * (q + 1) : r * (q + 1) + (xcd - r) * q) + off; }
        const int nig = WGM * nN, gid = wgid / nig, fm = gid * WGM, gsz = (nM - fm) < WGM ? (nM - fm) : WGM;
        u.pm = fm + ((wgid % nig) % gsz); u.pn = (wgid % nig) / gsz; return true;
    }
    __device__ __forceinline__ void a_ready(const Unit&) const {}
    __device__ __forceinline__ void done(const Unit&) const {}
};

__device__ __forceinline__ unsigned cvt_pk_bf16(float lo, float hi) { unsigned r; asm volatile("v_cvt_pk_bf16_f32 %0, %1, %2" : "=v"(r) : "v"(lo), "v"(hi)); return r; }
typedef float f32x2 __attribute__((ext_vector_type(2)));
#ifndef REP_EPI_GU
#define REP_EPI_GU 1
#endif
typedef unsigned u32x2 __attribute__((ext_vector_type(2)));
#ifndef NT_STORES
#define NT_STORES 0
#endif
#ifndef WT_STORES
#define WT_STORES 0
#endif
#ifndef LAST_UNIT_WT
#define LAST_UNIT_WT 0
#endif
#ifndef QKV_NT
#define QKV_NT 0
#endif
#ifndef RESID_WT
#define RESID_WT 1
#endif
__device__ __forceinline__ void store16_resid(void* p, u32x4 v) {
#if RESID_WT
    asm volatile("global_store_dwordx4 %0, %1, off sc1\n\ts_nop 1" :: "v"(p), "v"(v) : "memory");
#else
    *(u32x4*)p = v;
#endif
}
__device__ __forceinline__ void store16_sel(void* p, u32x4 v, bool wt) {
    if (wt) asm volatile("global_store_dwordx4 %0, %1, off sc1\n\ts_nop 1" :: "v"(p), "v"(v) : "memory");
    else *(u32x4*)p = v;
}
__device__ __forceinline__ void store16_out(void* p, u32x4 v) {
#if WT_STORES
    asm volatile("global_store_dwordx4 %0, %1, off sc1\n\ts_nop 1" :: "v"(p), "v"(v) : "memory");
#elif NT_STORES
    __builtin_nontemporal_store(v, (u32x4*)p);
#else
    *(u32x4*)p = v;
#endif
}
constexpr float RMS_EPS = 1e-6f, INV_DM = 1.0f / 1024.0f, LOG2E_F = 1.4426950408889634f;
typedef unsigned long long ssq_t;
constexpr float SSQ_SCALE = 1073741824.0f, SSQ_INV = 1.0f / 1073741824.0f;
__device__ __forceinline__ ssq_t ssq_enc(float s) { return (ssq_t)(s * SSQ_SCALE); }
__device__ __forceinline__ float rstd_of(const ssq_t* p) { return __builtin_amdgcn_rsqf((float)(*p) * (SSQ_INV * INV_DM) + RMS_EPS); }
template <int NAI> __device__ __forceinline__ void load_rstd8(const ssq_t* ssq, int row0, int fr, int fq, float sc, float (&rsv)[8]) {
    const float v0 = rstd_of(ssq + row0 + fq * 16) * sc, v1 = (NAI == 2) ? rstd_of(ssq + row0 + HALF + fq * 16) * sc : 0.f;
#pragma unroll
    for (int m = 0; m < 4; ++m) { rsv[m] = __shfl(v0, fr + 16 * m); rsv[4 + m] = (NAI == 2) ? __shfl(v1, fr + 16 * m) : 0.f; }
}
template <int NAI> __device__ __forceinline__ void load_rstd8_lds(PG8_LAS const ssq_t* ls, int rloc, int fr, int fq, float sc, float (&rsv)[8]) {
    const ssq_t s0 = ls[rloc + fq * 16], s1 = (NAI == 2) ? ls[rloc + HALF + fq * 16] : 0ull;
    const float v0 = __builtin_amdgcn_rsqf((float)s0 * (SSQ_INV * INV_DM) + RMS_EPS) * sc, v1 = (NAI == 2) ? __builtin_amdgcn_rsqf((float)s1 * (SSQ_INV * INV_DM) + RMS_EPS) * sc : 0.f;
#pragma unroll
    for (int m = 0; m < 4; ++m) { rsv[m] = __shfl(v0, fr + 16 * m); rsv[4 + m] = (NAI == 2) ? __shfl(v1, fr + 16 * m) : 0.f; }
}
#ifndef SSQ_PREFETCH
#define SSQ_PREFETCH 0
#endif
__device__ __forceinline__ float sigmoid_f(float x) { return __builtin_amdgcn_rcpf(1.0f + __builtin_amdgcn_exp2f(-LOG2E_F * x)); }

template <int MODE> struct EpiGate {
    static constexpr bool PERM = true, AFTER_DRAIN = false, RESID_PF = false, SSQ_PF = (SSQ_PREFETCH != 0), LAST_WT = (LAST_UNIT_WT != 0); static constexpr int REPS = (MODE == 1) ? REP_EPI_GU : 1;
    bf16_t* O; int ldc; const ssq_t* ssq; const float* bias; bool tiledO; bool wt = false; int probe = 0;
    __device__ __forceinline__ void operator()(const f32x4 (&acc)[2][2][4][2], const Unit& u, int wr, int wc, int fr, int fq) const { run<2>(acc, u, wr, wc, fr, fq, 0); }
    __device__ __forceinline__ void with_lds_ssq(const f32x4 (&acc)[2][2][4][2], const Unit& u, int wr, int wc, int fr, int fq, PG8_LAS const ssq_t* ls) const { run<2>(acc, u, wr, wc, fr, fq, 0, ls); }
    template <int NAI> __device__ __forceinline__ void run(const f32x4 (&acc)[2][2][4][2], const Unit& u, int wr, int wc, int fr, int fq, int rshift, PG8_LAS const ssq_t* ls = nullptr) const {
        if (probe == 1) return;
        const int row0 = u.pm * BM + rshift + wr * 64 + fr, col0 = u.pn * HALF + wc * 32 + 8 * fq;
        f32x4 b0[2], b1[2];
#pragma unroll
        for (int n = 0; n < 2; ++n) {
            if (MODE == 0) { b0[n] = *(const f32x4*)(bias + col0 + 4 * n); b1[n] = *(const f32x4*)(bias + 1024 + col0 + 4 * n); }
            else { b0[n] = (f32x4){0.f, 0.f, 0.f, 0.f}; b1[n] = b0[n]; } }
        float rsv[8]; if (ls) load_rstd8_lds<NAI>(ls, rshift + wr * 64 + fr, fr, fq, 1.0f, rsv); else load_rstd8<NAI>(ssq, row0, fr, fq, 1.0f, rsv);
#pragma unroll
        for (int ai = 0; ai < NAI; ++ai)
#pragma unroll
            for (int m = 0; m < 4; ++m) { const int row = row0 + ai * HALF + m * 16;
                const float rs = rsv[ai * 4 + m];
                u32x4 w; unsigned wv[4];
#pragma unroll
                for (int n = 0; n < 2; ++n) { f32x4 o, t, r;
                    if (MODE == 0) { const f32x4 p = acc[ai][0][m][n] * rs + b0[n]; t = (acc[ai][1][m][n] * rs + b1[n]) * (-LOG2E_F);
#pragma unroll
                        for (int i = 0; i < 4; ++i) t[i] = __builtin_amdgcn_exp2f(t[i]);
                        t = t + 1.0f;
#pragma unroll
                        for (int i = 0; i < 4; ++i) r[i] = __builtin_amdgcn_rcpf(t[i]);
                        o = p * r; }
                    else { t = acc[ai][0][m][n] * (rs * -LOG2E_F);
#pragma unroll
                        for (int i = 0; i < 4; ++i) t[i] = __builtin_amdgcn_exp2f(t[i]);
                        t = t + 1.0f;
#pragma unroll
                        for (int i = 0; i < 4; ++i) r[i] = __builtin_amdgcn_rcpf(t[i]);
                        o = (acc[ai][0][m][n] * acc[ai][1][m][n]) * (rs * rs) * r; }
                    wv[2 * n] = cvt_pk_bf16(o[0], o[1]); wv[2 * n + 1] = cvt_pk_bf16(o[2], o[3]); }
                w.x = wv[0]; w.y = wv[1]; w.z = wv[2]; w.w = wv[3];
                if (probe == 2) asm volatile("" :: "v"(w)); else store16_sel(tiledO ? O + tiled_off(row, col0, ldc) : O + (size_t)row * ldc + col0, w, wt); }
    }
};
struct EpiQkv {
    static constexpr bool PERM = true, AFTER_DRAIN = false, RESID_PF = false, SSQ_PF = (SSQ_PREFETCH != 0), LAST_WT = (LAST_UNIT_WT != 0); static constexpr int REPS = 1;
    bf16_t* O; int ldc; const ssq_t* ssq; int split_cols; size_t split_stride; float scale0; bool wt = false;
    __device__ __forceinline__ void operator()(const f32x4 (&acc)[2][2][4][2], const Unit& u, int wr, int wc, int fr, int fq) const { run<2>(acc, u, wr, wc, fr, fq, 0); }
    __device__ __forceinline__ void with_lds_ssq(const f32x4 (&acc)[2][2][4][2], const Unit& u, int wr, int wc, int fr, int fq, PG8_LAS const ssq_t* ls) const { run<2>(acc, u, wr, wc, fr, fq, 0, ls); }
    template <int NAI> __device__ __forceinline__ void run(const f32x4 (&acc)[2][2][4][2], const Unit& u, int wr, int wc, int fr, int fq, int rshift, PG8_LAS const ssq_t* ls = nullptr) const {
        const int row0 = u.pm * BM + rshift + wr * 64 + fr; int colt = u.pn * BM; bf16_t* base = O;
        float sc = 1.f; { const int t = colt / split_cols; base += (size_t)t * split_stride; colt -= t * split_cols; if (t == 0) sc = scale0; }
        const int col0 = colt + wc * 32 + 8 * fq;
        float rsv[8]; if (ls) load_rstd8_lds<NAI>(ls, rshift + wr * 64 + fr, fr, fq, sc, rsv); else load_rstd8<NAI>(ssq, row0, fr, fq, sc, rsv);
#pragma unroll
        for (int ai = 0; ai < NAI; ++ai)
#pragma unroll
            for (int m = 0; m < 4; ++m) { const int row = row0 + ai * HALF + m * 16;
                const float rs = rsv[ai * 4 + m];
                bf16_t* rowp = base + (size_t)row * ldc + col0;
#pragma unroll
                for (int bj = 0; bj < 2; ++bj) { const f32x4 v0 = acc[ai][bj][m][0] * rs, v1 = acc[ai][bj][m][1] * rs;
                    u32x4 w; w.x = cvt_pk_bf16(v0[0], v0[1]); w.y = cvt_pk_bf16(v0[2], v0[3]); w.z = cvt_pk_bf16(v1[0], v1[1]); w.w = cvt_pk_bf16(v1[2], v1[3]);
#if QKV_NT
                    __builtin_nontemporal_store(w, (u32x4*)(rowp + bj * HALF)); } }
#else
                    store16_sel(rowp + bj * HALF, w, wt); } }
#endif
    }
};
#ifndef RESID_PREFETCH
#define RESID_PREFETCH 1
#endif
template <bool BASE_F32, bool HAS_BIAS> struct EpiResid {
    static constexpr bool PERM = true, AFTER_DRAIN = false, RESID_PF = !BASE_F32 && (RESID_PREFETCH != 0), SSQ_PF = false, LAST_WT = false; static constexpr int REPS = 1;
    static constexpr int NB = BASE_F32 ? 2 : (HAS_BIAS ? 4 : 8);
    const float* basef; const bf16_t* xin; bf16_t* xb; int ldc; const float* bias; ssq_t* ssq_out;
    __device__ __forceinline__ void operator()(const f32x4 (&acc)[2][2][4][2], const Unit& u, int wr, int wc, int fr, int fq) const {
        const int row0 = u.pm * BM + wr * 64 + fr, col0 = u.pn * BM + wc * 32 + 8 * fq;
        f32x4 bv[2][2];
#pragma unroll
        for (int bj = 0; bj < 2; ++bj)
#pragma unroll
            for (int n = 0; n < 2; ++n) bv[bj][n] = HAS_BIAS ? *(const f32x4*)(bias + col0 + bj * HALF + n * 4) : (f32x4){0.f, 0.f, 0.f, 0.f};
        unsigned eoff0 = (unsigned)row0 * (unsigned)ldc + (unsigned)col0;
#pragma unroll
        for (int qb = 0; qb < 8; qb += NB) { asm volatile("" : "+v"(eoff0));
            u32x4 raw[NB][2]; f32x4 rawf[NB][2][2];
#pragma unroll
            for (int k = 0; k < NB; ++k) { const int q = qb + k; const unsigned eo = eoff0 + (unsigned)((q >> 2) * HALF + (q & 3) * 16) * (unsigned)ldc;
#pragma unroll
                for (int bj = 0; bj < 2; ++bj) {
                    if (BASE_F32) { rawf[k][bj][0] = *(const f32x4*)(basef + eo + bj * HALF); rawf[k][bj][1] = *(const f32x4*)(basef + eo + bj * HALF + 4); }
                    else raw[k][bj] = *(const u32x4*)(xin + eo + bj * HALF); } }
#pragma unroll
            for (int k = 0; k < NB; ++k) { const int q = qb + k, ai = q >> 2, m = q & 3; const unsigned eo = eoff0 + (unsigned)(ai * HALF + m * 16) * (unsigned)ldc;
                const int row = row0 + ai * HALF + m * 16; float s = 0.f;
#pragma unroll
                for (int bj = 0; bj < 2; ++bj) { f32x4 b0, b1;
                    if (BASE_F32) { b0 = rawf[k][bj][0]; b1 = rawf[k][bj][1]; }
                    else { const u32x4 w = raw[k][bj];
                        b0 = (f32x4){__uint_as_float(w.x << 16), __uint_as_float(w.x & 0xffff0000u), __uint_as_float(w.y << 16), __uint_as_float(w.y & 0xffff0000u)};
                        b1 = (f32x4){__uint_as_float(w.z << 16), __uint_as_float(w.z & 0xffff0000u), __uint_as_float(w.w << 16), __uint_as_float(w.w & 0xffff0000u)}; }
                    const f32x4 o0 = b0 + acc[ai][bj][m][0] + bv[bj][0], o1 = b1 + acc[ai][bj][m][1] + bv[bj][1];
                    u32x4 w; w.x = cvt_pk_bf16(o0[0], o0[1]); w.y = cvt_pk_bf16(o0[2], o0[3]); w.z = cvt_pk_bf16(o1[0], o1[1]); w.w = cvt_pk_bf16(o1[2], o1[3]);
                    store16_resid(xb + eo + bj * HALF, w);
                    s += (o0[0] * o0[0] + o0[1] * o0[1]) + (o0[2] * o0[2] + o0[3] * o0[3]) + (o1[0] * o1[0] + o1[1] * o1[1]) + (o1[2] * o1[2] + o1[3] * o1[3]); }
                s += __shfl_xor(s, 16); s += __shfl_xor(s, 32);
                if (fq == 0) atomicAdd(ssq_out + row, ssq_enc(s)); }
            asm volatile("" ::: "memory"); }
    }
    __device__ __forceinline__ unsigned pf_voff(const Unit& u, int wr, int wc, int fr, int fq) const {
        return ((unsigned)(u.pm * BM + wr * 64 + fr) * (unsigned)ldc + (unsigned)(u.pn * BM + wc * 32 + 8 * fq)) * 2u; }
    __device__ __forceinline__ const char* pf_base(int j) const { return (const char*)xin + (size_t)((j >> 2) * HALF + (j & 3) * 16) * (size_t)ldc * 2; }
    __device__ __forceinline__ void pf(const f32x4 (&acc)[2][2][4][2], const Unit& u, int wr, int wc, int fr, int fq, PG8_LAS unsigned char* lds, int wid, int lane) const {
        const int row0 = u.pm * BM + wr * 64 + fr, col0 = u.pn * BM + wc * 32 + 8 * fq;
        f32x4 bv[2][2];
#pragma unroll
        for (int bj = 0; bj < 2; ++bj)
#pragma unroll
            for (int n = 0; n < 2; ++n) bv[bj][n] = HAS_BIAS ? *(const f32x4*)(bias + col0 + bj * HALF + n * 4) : (f32x4){0.f, 0.f, 0.f, 0.f};
        const unsigned eoff0 = (unsigned)row0 * (unsigned)ldc + (unsigned)col0;
        u32x4 r7[2];
#pragma unroll
        for (int bj = 0; bj < 2; ++bj) r7[bj] = *(const u32x4*)(xin + eoff0 + (unsigned)(HALF + 48) * (unsigned)ldc + bj * HALF);
        const unsigned lo = (unsigned)wid * 1024u + (unsigned)lane * 16u;
#pragma unroll
        for (int qb = 0; qb < 8; qb += 4) {
            u32x4 raw[4][2];
#pragma unroll
            for (int k = 0; k < 4; ++k) { const int q = qb + k;
                const int slot = q == 0 ? 4 : q == 1 ? 5 : q == 2 ? 0 : q == 3 ? 1 : q == 4 ? 6 : q == 5 ? 7 : 2;
#pragma unroll
                for (int bj = 0; bj < 2; ++bj) { if (q < 7) raw[k][bj] = *(const PG8_LAS u32x4*)(lds + slot * HTB + bj * 8192 + lo); else raw[k][bj] = r7[bj]; } }
#pragma unroll
            for (int k = 0; k < 4; ++k) { const int q = qb + k, ai = q >> 2, m = q & 3; const unsigned eo = eoff0 + (unsigned)(ai * HALF + m * 16) * (unsigned)ldc;
                const int row = row0 + ai * HALF + m * 16; float s = 0.f;
#pragma unroll
                for (int bj = 0; bj < 2; ++bj) { const u32x4 w0 = raw[k][bj];
                    const f32x4 b0 = (f32x4){__uint_as_float(w0.x << 16), __uint_as_float(w0.x & 0xffff0000u), __uint_as_float(w0.y << 16), __uint_as_float(w0.y & 0xffff0000u)};
                    const f32x4 b1 = (f32x4){__uint_as_float(w0.z << 16), __uint_as_float(w0.z & 0xffff0000u), __uint_as_float(w0.w << 16), __uint_as_float(w0.w & 0xffff0000u)};
                    const f32x4 o0 = b0 + acc[ai][bj][m][0] + bv[bj][0], o1 = b1 + acc[ai][bj][m][1] + bv[bj][1];
                    u32x4 w; w.x = cvt_pk_bf16(o0[0], o0[1]); w.y = cvt_pk_bf16(o0[2], o0[3]); w.z = cvt_pk_bf16(o1[0], o1[1]); w.w = cvt_pk_bf16(o1[2], o1[3]);
                    store16_resid(xb + eo + bj * HALF, w);
                    s += (o0[0] * o0[0] + o0[1] * o0[1]) + (o0[2] * o0[2] + o0[3] * o0[3]) + (o1[0] * o1[0] + o1[1] * o1[1]) + (o1[2] * o1[2] + o1[3] * o1[3]); }
                s += __shfl_xor(s, 16); s += __shfl_xor(s, 32);
                if (fq == 0) atomicAdd(ssq_out + row, ssq_enc(s)); } }
    }
};

struct EpiFinal {
    static constexpr bool PERM = true, AFTER_DRAIN = false, RESID_PF = false, SSQ_PF = false, LAST_WT = false; static constexpr int REPS = 1;
    const bf16_t* xin; float* out; int ldc; const float* gain; ssq_t* ssq; unsigned* cnt; PG8_LAS unsigned* flag; unsigned want;
    __device__ __forceinline__ void operator()(const f32x4 (&acc_)[2][2][4][2], const Unit& u, int wr, int wc, int fr, int fq) const {
        f32x4 (&acc)[2][2][4][2] = const_cast<f32x4 (&)[2][2][4][2]>(acc_);
        const int row0 = u.pm * BM + wr * 64 + fr, col0 = u.pn * BM + wc * 32 + 8 * fq, lane = fr + 16 * fq, wid = wr * 4 + wc;
        unsigned eoff0 = (unsigned)row0 * (unsigned)ldc + (unsigned)col0;
#pragma unroll
        for (int qb = 0; qb < 8; qb += 4) { asm volatile("" : "+v"(eoff0));
            u32x4 raw[4][2];
#pragma unroll
            for (int k = 0; k < 4; ++k) { const int q = qb + k; const unsigned eo = eoff0 + (unsigned)((q >> 2) * HALF + (q & 3) * 16) * (unsigned)ldc;
#pragma unroll
                for (int bj = 0; bj < 2; ++bj) raw[k][bj] = *(const u32x4*)(xin + eo + bj * HALF); }
#pragma unroll
            for (int k = 0; k < 4; ++k) { const int q = qb + k, ai = q >> 2, m = q & 3; const int row = row0 + ai * HALF + m * 16; float s = 0.f;
#pragma unroll
                for (int bj = 0; bj < 2; ++bj) { const u32x4 w = raw[k][bj];
                    const f32x4 b0 = (f32x4){__uint_as_float(w.x << 16), __uint_as_float(w.x & 0xffff0000u), __uint_as_float(w.y << 16), __uint_as_float(w.y & 0xffff0000u)};
                    const f32x4 b1 = (f32x4){__uint_as_float(w.z << 16), __uint_as_float(w.z & 0xffff0000u), __uint_as_float(w.w << 16), __uint_as_float(w.w & 0xffff0000u)};
                    const f32x4 o0 = b0 + acc[ai][bj][m][0], o1 = b1 + acc[ai][bj][m][1]; acc[ai][bj][m][0] = o0; acc[ai][bj][m][1] = o1;
                    s += (o0[0] * o0[0] + o0[1] * o0[1]) + (o0[2] * o0[2] + o0[3] * o0[3]) + (o1[0] * o1[0] + o1[1] * o1[1]) + (o1[2] * o1[2] + o1[3] * o1[3]); }
                s += __shfl_xor(s, 16); s += __shfl_xor(s, 32);
                if (fq == 0) atomicAdd(ssq + row, ssq_enc(s)); }
            asm volatile("" ::: "memory"); }
        asm volatile("s_waitcnt vmcnt(0)" ::: "memory");
        if (lane == 0) __hip_atomic_fetch_add(cnt + 64 * u.pm, 1u, __ATOMIC_RELAXED, __HIP_MEMORY_SCOPE_AGENT);
        if (wid == 0) {
            const unsigned long long t0 = __builtin_amdgcn_s_memrealtime();
            for (;;) {
                if ((unsigned)__builtin_amdgcn_readfirstlane(__hip_atomic_load(cnt + 64 * u.pm, __ATOMIC_RELAXED, __HIP_MEMORY_SCOPE_AGENT)) >= want) break;
                if (__builtin_amdgcn_s_memrealtime() - t0 > 2000000ull) break;
                __builtin_amdgcn_s_sleep(2); }
            __builtin_amdgcn_fence(__ATOMIC_ACQUIRE, "agent");
        }
        asm volatile("s_waitcnt vmcnt(0) lgkmcnt(0)" ::: "memory"); __builtin_amdgcn_s_barrier(); asm volatile("" ::: "memory");
        float rsv[8];
        { const ssq_t t0 = __hip_atomic_load(ssq + row0 + fq * 16, __ATOMIC_RELAXED, __HIP_MEMORY_SCOPE_AGENT), t1 = __hip_atomic_load(ssq + row0 + HALF + fq * 16, __ATOMIC_RELAXED, __HIP_MEMORY_SCOPE_AGENT);
          const float v0 = __builtin_amdgcn_rsqf((float)t0 * (SSQ_INV * INV_DM) + RMS_EPS), v1 = __builtin_amdgcn_rsqf((float)t1 * (SSQ_INV * INV_DM) + RMS_EPS);
#pragma unroll
          for (int m = 0; m < 4; ++m) { rsv[m] = __shfl(v0, fr + 16 * m); rsv[4 + m] = __shfl(v1, fr + 16 * m); } }
        f32x4 gv[2][2];
#pragma unroll
        for (int bj = 0; bj < 2; ++bj)
#pragma unroll
            for (int n = 0; n < 2; ++n) gv[bj][n] = *(const f32x4*)(gain + col0 + bj * HALF + n * 4);
#pragma unroll
        for (int ai = 0; ai < 2; ++ai)
#pragma unroll
            for (int m = 0; m < 4; ++m) { const float rs = rsv[ai * 4 + m]; float* orow = out + (size_t)(row0 + ai * HALF + m * 16) * ldc + col0;
#pragma unroll
                for (int bj = 0; bj < 2; ++bj)
#pragma unroll
                    for (int n = 0; n < 2; ++n) __builtin_nontemporal_store(acc[ai][bj][m][n] * rs * gv[bj][n], (f32x4*)(orow + bj * HALF + n * 4)); }
    }
};
#ifndef STATIC_PRIO
#define STATIC_PRIO 0
#endif
#ifndef TILED_A
#define TILED_A false
#endif
#ifndef TILED_B
#define TILED_B true
#endif
template <class Epi, class Sched, bool ALIGN_EPI = false, bool SP2 = false>
__device__ __forceinline__ void gemm_phase(PG8_LAS unsigned char* lds, const Gemm g, const Sched& S, const Epi& E) {
    int tid = threadIdx.x; asm volatile("" : "+v"(tid));
    const int wid = __builtin_amdgcn_readfirstlane(tid >> 6), lane = tid & 63, wr = wid >> 2, wc = wid & 3, fr = lane & 15, fq = lane >> 4;
    const int K = g.K, nt = K / BK, LDA = g.lda ? g.lda : K;
    unsigned voffA[2], voffB[2];
#pragma unroll
    for (int i = 0; i < 2; ++i) { int R, C; stage_rc(tid * 16 + i * 8192, R, C); const int Rb = Epi::PERM ? ((R & ~31) + perm32(R & 31)) : R;
        voffA[i] = g.tiledA ? (unsigned)(R * BK + C) * 2u : (unsigned)(R * LDA + C) * 2u; voffB[i] = TILED_B ? (unsigned)(Rb * BK + C) * 2u : (unsigned)(Rb * K + C) * 2u; }
    const size_t kstep = (size_t)(BK * 2);
    const size_t hstep = (size_t)HALF * K * 2;
    const size_t tstep = 2 * hstep;
    const size_t hstepAr = (size_t)HALF * LDA * 2, tstepA = g.tiledA ? tstep : 2 * hstepAr;
    const size_t kstepT = (size_t)HTB, hstepT = (size_t)nt * HTB;
    const size_t kstepA = g.tiledA ? kstepT : kstep, hstepA = g.tiledA ? hstepT : hstepAr, kstepB = TILED_B ? kstepT : kstep, hstepB = TILED_B ? hstepT : hstep;
    const unsigned ldsw = (unsigned)wid * 1024u;
    const int aoff = lds_byte(wr * 64 + fr, fq * 8), boff = lds_byte(wc * 32 + fr, fq * 8);
#define PG8_SA(b, h) (((b) * 2 + (h)) * HTB)
#define PG8_SB(b, h) ((4 + (b) * 2 + (h)) * HTB)
#define PG8_STAGE(bufoff, gbase, voff) do { _Pragma("unroll") for (int _i = 0; _i < 2; ++_i) \
        __builtin_amdgcn_global_load_lds((const unsigned*)((const char*)(gbase) + (voff)[_i]), (PG8_LAS unsigned*)(lds + (bufoff) + ldsw + _i * 8192), 16, 0, 0); } while (0)
#define PG8_SSQ_DMA(slot_, pm_) do { if (wid < 2) __builtin_amdgcn_global_load_lds((const unsigned*)((const char*)(E.ssq + (size_t)(pm_) * BM) + wid * 1024 + lane * 16), (PG8_LAS unsigned*)(lds + STAGE_BYTES + (slot_) * 2048 + wid * 1024), 16, 0, 0); } while (0)
#define PG8_LDA(dst, b, h) do { _Pragma("unroll") for (int m = 0; m < 4; ++m) _Pragma("unroll") for (int k = 0; k < 2; ++k) dst[m][k] = *(const PG8_LAS bf16x8*)(lds + PG8_SA(b, h) + aoff + m * 2048 + k * 1024); } while (0)
#define PG8_LDB(dst, b, h) do { _Pragma("unroll") for (int n = 0; n < 2; ++n) _Pragma("unroll") for (int k = 0; k < 2; ++k) dst[n][k] = *(const PG8_LAS bf16x8*)(lds + PG8_SB(b, h) + boff + n * 2048 + k * 1024); } while (0)
#define PG8_MMA(ai, bj, At, Bt) do { if (!STATIC_PRIO) __builtin_amdgcn_s_setprio(1); _Pragma("unroll") for (int m = 0; m < 4; ++m) _Pragma("unroll") for (int n = 0; n < 2; ++n) _Pragma("unroll") for (int k = 0; k < 2; ++k) \
        acc[ai][bj][m][n] = __builtin_amdgcn_mfma_f32_16x16x32_bf16(Bt[n][k], At[m][k], acc[ai][bj][m][n], 0, 0, 0); if (!STATIC_PRIO) __builtin_amdgcn_s_setprio(0); } while (0)
#define PG8_WAIT_V(n) asm volatile("s_waitcnt vmcnt(" #n ")" ::: "memory")
#define PG8_WAIT_L(n) asm volatile("s_waitcnt lgkmcnt(" #n ")" ::: "memory")
#define PG8_BAR __builtin_amdgcn_s_barrier()
#define PG8_SCHED __builtin_amdgcn_sched_barrier(0)
    if (STATIC_PRIO) { if (wid >= 4) __builtin_amdgcn_s_setprio(1); }
    Unit cur, nxt; int ui = 0;
    if (!S.next(0, cur)) return;
    f32x4 acc[2][2][4][2];
#pragma unroll
    for (int a = 0; a < 2; ++a)
#pragma unroll
        for (int b = 0; b < 2; ++b)
#pragma unroll
            for (int m = 0; m < 4; ++m)
#pragma unroll
                for (int n = 0; n < 2; ++n) acc[a][b][m][n] = (f32x4){0.f, 0.f, 0.f, 0.f};
    bf16x8 At[4][2], B0[2][2], B1[2][2];
    const char* cA = (const char*)g.A + (size_t)cur.pm * tstepA; const char* cB = (const char*)g.Bt + (size_t)cur.pn * tstep;
    S.a_ready(cur);
    if constexpr (Epi::SSQ_PF) PG8_SSQ_DMA(0, cur.pm);
    if constexpr (SP2) {
        PG8_STAGE(PG8_SB(0, 0), cB, voffB); PG8_STAGE(PG8_SB(0, 1), cB + hstepB, voffB); PG8_STAGE(PG8_SA(0, 0), cA, voffA); PG8_STAGE(PG8_SA(0, 1), cA + hstepA, voffA);
        if (wr == 1) PG8_BAR;
        PG8_WAIT_V(2); PG8_BAR;
        PG8_STAGE(PG8_SB(1, 0), cB + kstepB, voffB); PG8_STAGE(PG8_SA(1, 0), cA + kstepA, voffA); PG8_STAGE(PG8_SB(1, 1), cB + hstepB + kstepB, voffB);
        PG8_WAIT_V(6); PG8_BAR;
    } else {
        PG8_STAGE(PG8_SB(0, 0), cB, voffB); PG8_STAGE(PG8_SA(0, 0), cA, voffA); PG8_STAGE(PG8_SB(0, 1), cB + hstepB, voffB); PG8_STAGE(PG8_SA(0, 1), cA + hstepA, voffA);
        if (wr == 1) PG8_BAR;
        PG8_WAIT_V(4); PG8_BAR;
        PG8_STAGE(PG8_SB(1, 0), cB + kstepB, voffB); PG8_STAGE(PG8_SA(1, 0), cA + kstepA, voffA); PG8_STAGE(PG8_SB(1, 1), cB + hstepB + kstepB, voffB);
        PG8_WAIT_V(6); PG8_BAR;
    }
    for (;;) {
        const bool has_next = S.next(ui + 1, nxt);
        const char* nA = has_next ? (const char*)g.A + (size_t)nxt.pm * tstepA : cA; const char* nB = has_next ? (const char*)g.Bt + (size_t)nxt.pn * tstep : cB;
        for (int t = 0; t < nt; t += 2) {
            const bool last = (t == nt - 2);
            const char* a1 = cA + (size_t)(t + 1) * kstepA;
            const char* a2 = last ? nA : cA + (size_t)(t + 2) * kstepA; const char* b2 = last ? nB : cB + (size_t)(t + 2) * kstepB;
            const char* a3 = a2 + kstepA; const char* b3 = b2 + kstepB;
            if (last && has_next) { S.a_ready(nxt); if constexpr (Epi::SSQ_PF) PG8_SSQ_DMA((ui + 1) & 1, nxt.pm); }
            unsigned wB[2] = {voffB[0], voffB[1]}, wA[2] = {voffA[0], voffA[1]};
            const char *s0 = b2, *s1 = b2 + hstepB, *s2 = a2, *s3 = a2 + hstepA, *s4 = b3, *s5 = b3 + hstepB, *s6 = a3;
            if constexpr (SP2 && Epi::RESID_PF) { if (last && !has_next) {
                int t2 = threadIdx.x; asm volatile("" : "+v"(t2));
                const unsigned v0 = E.pf_voff(cur, wr, wc, t2 & 15, (t2 & 63) >> 4), v1 = v0 + (unsigned)(HALF * 2);
                wB[0] = v0; wB[1] = v1; wA[0] = v0; wA[1] = v1;
                s0 = E.pf_base(0); s1 = E.pf_base(1); s2 = E.pf_base(2); s3 = E.pf_base(3); s4 = E.pf_base(4); s5 = E.pf_base(5); s6 = E.pf_base(6); } }
            if constexpr (SP2) {
            PG8_LDB(B0, 0, 0); PG8_LDB(B1, 0, 1); PG8_SCHED; PG8_LDA(At, 0, 0); PG8_STAGE(PG8_SA(1, 1), a1 + hstepA, voffA);
            PG8_WAIT_V(8); PG8_WAIT_L(0); PG8_BAR; PG8_MMA(0, 0, At, B0); PG8_MMA(0, 1, At, B1); PG8_BAR; PG8_SCHED;
            PG8_LDA(At, 0, 1); PG8_STAGE(PG8_SB(0, 0), s0, wB); PG8_STAGE(PG8_SB(0, 1), s1, wB); PG8_STAGE(PG8_SA(0, 0), s2, wA);
            PG8_WAIT_V(8); PG8_WAIT_L(0); PG8_BAR; PG8_MMA(1, 0, At, B0); PG8_MMA(1, 1, At, B1); PG8_BAR; PG8_SCHED;
            PG8_LDB(B0, 1, 0); PG8_LDB(B1, 1, 1); PG8_SCHED; PG8_LDA(At, 1, 0); PG8_STAGE(PG8_SA(0, 1), s3, wA);
            PG8_WAIT_V(8); PG8_WAIT_L(0); PG8_BAR; PG8_MMA(0, 0, At, B0); PG8_MMA(0, 1, At, B1); PG8_BAR; PG8_SCHED;
            PG8_LDA(At, 1, 1); PG8_STAGE(PG8_SB(1, 0), s4, wB); PG8_STAGE(PG8_SB(1, 1), s5, wB); PG8_STAGE(PG8_SA(1, 0), s6, wA);
            PG8_WAIT_V(8); PG8_WAIT_L(0); PG8_BAR; PG8_MMA(1, 0, At, B0); PG8_MMA(1, 1, At, B1); PG8_BAR; PG8_SCHED;
            } else {
            PG8_LDB(B0, 0, 0); PG8_SCHED; PG8_LDA(At, 0, 0); PG8_STAGE(PG8_SA(1, 1), a1 + hstepA, voffA);
            PG8_WAIT_L(8); PG8_BAR; PG8_WAIT_L(0); PG8_MMA(0, 0, At, B0); PG8_BAR; PG8_SCHED;
            PG8_LDB(B1, 0, 1); PG8_STAGE(PG8_SB(0, 0), b2, voffB);
            PG8_BAR; PG8_WAIT_L(0); PG8_MMA(0, 1, At, B1); PG8_BAR;
            PG8_LDA(At, 0, 1); PG8_STAGE(PG8_SA(0, 0), a2, voffA);
            PG8_BAR; PG8_WAIT_L(0); PG8_MMA(1, 0, At, B0); PG8_BAR; PG8_SCHED;
            PG8_STAGE(PG8_SB(0, 1), b2 + hstepB, voffB);
            PG8_WAIT_V(6); PG8_BAR; PG8_MMA(1, 1, At, B1); PG8_BAR;
            PG8_LDB(B0, 1, 0); PG8_SCHED; PG8_LDA(At, 1, 0); PG8_STAGE(PG8_SA(0, 1), a2 + hstepA, voffA);
            PG8_WAIT_L(8); PG8_BAR; PG8_WAIT_L(0); PG8_MMA(0, 0, At, B0); PG8_BAR; PG8_SCHED;
            PG8_LDB(B1, 1, 1); PG8_STAGE(PG8_SB(1, 0), b3, voffB);
            PG8_BAR; PG8_WAIT_L(0); PG8_MMA(0, 1, At, B1); PG8_BAR;
            PG8_LDA(At, 1, 1); PG8_STAGE(PG8_SA(1, 0), a3, voffA);
            PG8_BAR; PG8_WAIT_L(0); PG8_MMA(1, 0, At, B0); PG8_BAR; PG8_SCHED;
            PG8_STAGE(PG8_SB(1, 1), b3 + hstepB, voffB);
            PG8_WAIT_V(6); PG8_BAR; PG8_MMA(1, 1, At, B1); PG8_BAR;
            }
        }
        if constexpr (ALIGN_EPI) { if (wr == 0) PG8_BAR; }
        if constexpr (SP2 && Epi::RESID_PF) { if (!has_next) { PG8_WAIT_V(0); E.pf(acc, cur, wr, wc, fr, fq, lds, wid, lane); } else E(acc, cur, wr, wc, fr, fq); S.done(cur); }
        else if constexpr (Epi::SSQ_PF) { for (int re_ = 0; re_ < Epi::REPS; ++re_) { E.with_lds_ssq(acc, cur, wr, wc, fr, fq, (PG8_LAS const ssq_t*)(lds + STAGE_BYTES + (ui & 1) * 2048)); asm volatile("" ::: "memory"); } S.done(cur); }
        else if constexpr (Epi::LAST_WT) { Epi E2 = E; E2.wt = !has_next; for (int re_ = 0; re_ < Epi::REPS; ++re_) { E2(acc, cur, wr, wc, fr, fq); asm volatile("" ::: "memory"); } S.done(cur); }
        else if constexpr (!Epi::AFTER_DRAIN) { for (int re_ = 0; re_ < Epi::REPS; ++re_) { E(acc, cur, wr, wc, fr, fq); asm volatile("" ::: "memory"); } S.done(cur);
#ifdef EPI_DRAIN_PROBE
            PG8_WAIT_V(0);
#endif
        }
        if (!has_next) break;
#pragma unroll
        for (int a = 0; a < 2; ++a)
#pragma unroll
            for (int b = 0; b < 2; ++b)
#pragma unroll
                for (int m = 0; m < 4; ++m)
#pragma unroll
                    for (int n = 0; n < 2; ++n) acc[a][b][m][n] = (f32x4){0.f, 0.f, 0.f, 0.f};
        cur = nxt; cA = nA; cB = nB; ++ui;
        if constexpr (ALIGN_EPI) { if (wr == 1) PG8_BAR; }
    }
    if (STATIC_PRIO) __builtin_amdgcn_s_setprio(0);
    PG8_WAIT_V(0);
    if constexpr (!ALIGN_EPI) { if (wr == 0) PG8_BAR; }
    PG8_BAR;
    if constexpr (Epi::AFTER_DRAIN) { E.fused(acc, cur, wr, wc, fr, fq, lds, wid, lane); S.done(cur); }
#undef PG8_SA
#undef PG8_SB
#undef PG8_STAGE
#undef PG8_SSQ_DMA
#undef PG8_LDA
#undef PG8_LDB
#undef PG8_MMA
#undef PG8_WAIT_V
#undef PG8_WAIT_L
#undef PG8_BAR
#undef PG8_SCHED
}
constexpr int HALF_RING_BYTES = 3 * 3 * HTB;
template <class Epi>
__device__ __forceinline__ void gemm_half_phase(PG8_LAS unsigned char* lds, const Gemm g, const StaticOrder& S, const Epi& E) {
    int tid = threadIdx.x; asm volatile("" : "+v"(tid));
    const int wid = __builtin_amdgcn_readfirstlane(tid >> 6), lane = tid & 63, wr = wid >> 2, wc = wid & 3, fr = lane & 15, fq = lane >> 4;
    const int K = g.K, nt = K / BK, nhalf = 2 * (S.nwg - S.lim);
    unsigned voffA[2], voffB[2];
#pragma unroll
    for (int i = 0; i < 2; ++i) { int R, C; stage_rc(tid * 16 + i * 8192, R, C); const int Rb = Epi::PERM ? ((R & ~31) + perm32(R & 31)) : R;
        voffA[i] = TILED_A ? (unsigned)(R * BK + C) * 2u : (unsigned)(R * K + C) * 2u; voffB[i] = TILED_B ? (unsigned)(Rb * BK + C) * 2u : (unsigned)(Rb * K + C) * 2u; }
    const size_t kstep = (size_t)(BK * 2), hstep = (size_t)HALF * K * 2, tstep = 2 * hstep, kstepT = (size_t)HTB, hstepT = (size_t)nt * HTB;
    const size_t kstepA = TILED_A ? kstepT : kstep, hstepA = TILED_A ? hstepT : hstep, kstepB = TILED_B ? kstepT : kstep, hstepB = TILED_B ? hstepT : hstep;
    const unsigned ldsw = (unsigned)wid * 1024u;
    const int aoff = lds_byte(wr * 64 + fr, fq * 8), boff = lds_byte(wc * 32 + fr, fq * 8);
#define PH_STAGE(bufoff, gbase, voff) do { _Pragma("unroll") for (int _i = 0; _i < 2; ++_i) \
        __builtin_amdgcn_global_load_lds((const unsigned*)((const char*)(gbase) + (voff)[_i]), (PG8_LAS unsigned*)(lds + (bufoff) + ldsw + _i * 8192), 16, 0, 0); } while (0)
#define PH_STAGE3(slot, ka_, kb_) do { PH_STAGE((slot), kb_, voffB); PH_STAGE((slot) + HTB, (kb_) + hstepB, voffB); PH_STAGE((slot) + 2 * HTB, ka_, voffA); } while (0)
#define PH_MMA(bj, At, Bt) do { __builtin_amdgcn_s_setprio(1); _Pragma("unroll") for (int m = 0; m < 4; ++m) _Pragma("unroll") for (int n = 0; n < 2; ++n) _Pragma("unroll") for (int k = 0; k < 2; ++k) \
        acc[0][bj][m][n] = __builtin_amdgcn_mfma_f32_16x16x32_bf16(Bt[n][k], At[m][k], acc[0][bj][m][n], 0, 0, 0); __builtin_amdgcn_s_setprio(0); } while (0)
    for (int h = (int)blockIdx.x; h < nhalf; h += S.G) {
        Unit u; S.unit_at((long)S.lim + (h >> 1), u); const int hsel = h & 1;
        f32x4 acc[2][2][4][2];
#pragma unroll
        for (int b = 0; b < 2; ++b)
#pragma unroll
            for (int m = 0; m < 4; ++m)
#pragma unroll
                for (int n = 0; n < 2; ++n) { acc[0][b][m][n] = (f32x4){0.f, 0.f, 0.f, 0.f}; acc[1][b][m][n] = (f32x4){0.f, 0.f, 0.f, 0.f}; }
        bf16x8 At[4][2], B0[2][2], B1[2][2];
        const char* ka = (const char*)g.A + (size_t)u.pm * tstep + (size_t)hsel * hstepA; const char* kb = (const char*)g.Bt + (size_t)u.pn * tstep;
        PH_STAGE3(0, ka, kb); PH_STAGE3(3 * HTB, ka + kstepA, kb + kstepB);
        asm volatile("s_waitcnt vmcnt(6)" ::: "memory"); __builtin_amdgcn_s_barrier(); __builtin_amdgcn_sched_barrier(0);
        int cur = 0, nxt2 = 6 * HTB;
        for (int t = 0; t < nt; ++t) {
            const bool more = (t + 2 < nt);
            if (more) PH_STAGE3(nxt2, ka + 2 * kstepA, kb + 2 * kstepB);
            const PG8_LAS unsigned char* sl = lds + cur;
#pragma unroll
            for (int n = 0; n < 2; ++n)
#pragma unroll
                for (int k = 0; k < 2; ++k) { B0[n][k] = *(const PG8_LAS bf16x8*)(sl + boff + n * 2048 + k * 1024); B1[n][k] = *(const PG8_LAS bf16x8*)(sl + HTB + boff + n * 2048 + k * 1024); }
#pragma unroll
            for (int m = 0; m < 4; ++m)
#pragma unroll
                for (int k = 0; k < 2; ++k) At[m][k] = *(const PG8_LAS bf16x8*)(sl + 2 * HTB + aoff + m * 2048 + k * 1024);
            asm volatile("s_waitcnt lgkmcnt(0)" ::: "memory"); __builtin_amdgcn_sched_barrier(0);
            PH_MMA(0, At, B0); PH_MMA(1, At, B1);
            if (more) asm volatile("s_waitcnt vmcnt(6)" ::: "memory"); else asm volatile("s_waitcnt vmcnt(0)" ::: "memory");
            __builtin_amdgcn_s_barrier(); __builtin_amdgcn_sched_barrier(0);
            ka += kstepA; kb += kstepB; cur = (cur == 6 * HTB) ? 0 : cur + 3 * HTB; nxt2 = (nxt2 == 6 * HTB) ? 0 : nxt2 + 3 * HTB;
        }
        E.template run<1>(acc, u, wr, wc, fr, fq, hsel * HALF);
    }
    asm volatile("s_waitcnt lgkmcnt(0)" ::: "memory"); __builtin_amdgcn_s_barrier();
#undef PH_STAGE
#undef PH_STAGE3
#undef PH_MMA
}
}
#ifndef ATT_LOAD_POS
#define ATT_LOAD_POS 0
#endif
#ifndef ATT_WT
#define ATT_WT 0
#endif
#ifndef SCALE_WT
#define SCALE_WT 0
#endif
#ifndef ROWS_PER_TRIP
#define ROWS_PER_TRIP 8
#endif
namespace dattn {
typedef short bf16x8 __attribute__((ext_vector_type(8)));
typedef short s16x4 __attribute__((ext_vector_type(4)));
typedef float f32x16 __attribute__((ext_vector_type(16)));
typedef unsigned u32x4 __attribute__((ext_vector_type(4)));
#define DA_LAS __attribute__((address_space(3)))
constexpr int SEQ = 8192, NH = 12, HD = 64, DA = NH * HD, NKEY = 384, KROW = 144;
constexpr int TB = 192;
constexpr int LDS_K = 0, K_BYTES = NKEY * KROW, LDS_V = K_BYTES, V_HALF = NKEY * 64, LDS_OST = LDS_V + 2 * V_HALF, LDS_ALLB = LDS_OST + 8 * 4096, LDS_NEG = LDS_ALLB + NH * TB * 4, LDS_END = LDS_NEG + 64 * 4;
constexpr int NUNITS = 2 * NH * 32;
__device__ const unsigned char T5_BUCKET[3][132] = {
 {0,1,2,3,4,5,6,7,8,9,10,11,12,13,14,15,16,16,16,16,16,16,17,17,17,17,17,17,17,17,18,18,18,18,18,18,18,18,18,18,19,19,19,19,19,19,19,19,19,19,19,19,19,19,20,20,20,20,20,20,20,20,20,20,20,20,20,20,20,20,20,20,20,21,21,21,21,21,21,21,21,21,21,21,21,21,21,21,21,21,21,21,21,21,21,21,21,21,21,22,22,22,22,22,22,22,22,22,22,22,22,22,22,22,22,22,22,22,22,22,22,22,22,22,22,22,22,22,22,0,0,0},
 {0,4,8,12,16,16,17,17,18,18,19,19,19,19,20,20,20,20,20,21,21,21,21,21,21,22,22,22,22,22,22,22,22,22,23,23,23,23,23,23,23,23,23,23,23,23,24,24,24,24,24,24,24,24,24,24,24,24,24,24,24,24,25,25,25,25,25,25,25,25,25,25,25,25,25,25,25,25,25,25,25,25,25,26,26,26,26,26,26,26,26,26,26,26,26,26,26,26,26,26,26,26,26,26,26,26,26,26,26,26,26,26,26,27,27,27,27,27,27,27,27,27,27,27,27,27,27,27,27,0,0,0},
 {0,16,18,19,20,21,21,22,22,23,23,23,24,24,24,24,25,25,25,25,25,26,26,26,26,26,26,26,26,27,27,27,27,27,27,27,27,27,27,28,28,28,28,28,28,28,28,28,28,28,28,28,29,29,29,29,29,29,29,29,29,29,29,29,29,29,29,29,29,29,30,30,30,30,30,30,30,30,30,30,30,30,30,30,30,30,30,30,30,30,30,30,30,30,30,31,31,31,31,31,31,31,31,31,31,31,31,31,31,31,31,31,31,31,31,31,31,31,31,31,31,31,31,31,31,31,31,31,31,0,0,0}};
__device__ __forceinline__ int crow(int r, int hi) { return (r & 3) + 8 * (r >> 2) + 4 * hi; }
__device__ __forceinline__ unsigned cvtpk(float lo, float hi) { unsigned r; asm volatile("v_cvt_pk_bf16_f32 %0, %1, %2" : "=v"(r) : "v"(lo), "v"(hi)); return r; }
typedef short v4i16_t __attribute__((ext_vector_type(4)));
__device__ __forceinline__ s16x4 vtr(DA_LAS const char* p) { return __builtin_bit_cast(s16x4, __builtin_amdgcn_ds_read_tr16_b64_v4i16((DA_LAS v4i16_t*)p)); }

struct UnitGeom { int b, h, g, dsh, r, I0; };
__device__ __forceinline__ UnitGeom unit_geom(int unit) {
    UnitGeom u; const int bh = unit >> 5, u32i = unit & 31; u.b = bh / NH; u.h = bh % NH; u.g = u.h >> 2; u.dsh = 2 * u.g;
    const int cps = 32 >> u.dsh;
    u.r = u32i / cps; u.I0 = (u32i % cps) * 256; return u;
}
struct UnitRegs { u32x4 kv[6], vv[6]; bf16x8 qr[4]; };
__device__ __forceinline__ void attn_load(int unit, const unsigned short* Q, const unsigned short* K, const unsigned short* V, UnitRegs& R, int tid) {
    const UnitGeom u = unit_geom(unit); const size_t rowbase = (size_t)u.b * SEQ;
    const int lane = tid & 63, q32 = lane & 31, hi = lane >> 5, wid = tid >> 6;
#pragma unroll
    for (int it = 0; it < 6; ++it) { const int idx = tid + 512 * it, row = idx >> 3, ch = idx & 7, J = u.I0 - 128 + row;
        const int Jc = J < 0 ? 0 : J; const size_t ga = (rowbase + (size_t)((Jc << u.dsh) + u.r)) * DA + u.h * HD + ch * 8;
        R.kv[it] = *(const u32x4*)(K + ga); R.vv[it] = *(const u32x4*)(V + ga); }
    const size_t qtok = rowbase + (size_t)(((u.I0 + 32 * wid + q32) << u.dsh) + u.r);
#pragma unroll
    for (int s = 0; s < 4; ++s) R.qr[s] = __builtin_nontemporal_load((const bf16x8*)(Q + qtok * DA + u.h * HD + s * 16 + hi * 8));
}
__device__ __forceinline__ void attn_stage(int unit, const UnitRegs& R, const float* rel_bias, DA_LAS char* lds, int tid) {
    const UnitGeom u = unit_geom(unit);
#pragma unroll
    for (int it = 0; it < 6; ++it) { const int idx = tid + 512 * it, row = idx >> 3, ch = idx & 7; const bool ok = (u.I0 - 128 + row) >= 0; const u32x4 z = (u32x4){0u, 0u, 0u, 0u};
        *(DA_LAS u32x4*)(lds + LDS_K + row * KROW + ch * 16) = ok ? R.kv[it] : z;
        *(DA_LAS u32x4*)(lds + LDS_V + (ch >> 2) * V_HALF + row * 64 + (ch & 3) * 16) = ok ? R.vv[it] : z; }
}
__device__ __forceinline__ void attn_compute(int unit, const bf16x8 (&qr)[4], unsigned short* O, float* lse2, DA_LAS char* lds, int tid) {
    const int lane = tid & 63, q32 = lane & 31, hi = lane >> 5; const int wid = __builtin_amdgcn_readfirstlane(tid >> 6);
    const UnitGeom ug = unit_geom(unit); const int h = ug.h, dsh = ug.dsh, r = ug.r, I0 = ug.I0;
    const size_t rowbase = (size_t)ug.b * SEQ;
    const int Iq = I0 + 32 * wid + q32;
    const size_t qtok = rowbase + (size_t)((Iq << dsh) + r);
    const int Jw = I0 + 32 * wid - 128;
    const DA_LAS float* bias = (const DA_LAS float*)(lds + LDS_ALLB) + h * TB + (q32 - 4 * hi);
    const DA_LAS float* negt = (const DA_LAS float*)(lds + LDS_NEG) + (q32 - 4 * hi);
    f32x16 st[5];
#pragma unroll
    for (int kt = 0; kt < 5; ++kt) { const DA_LAS char* kp = lds + LDS_K + (32 * (wid + kt) + q32) * KROW + hi * 16;
        const bool tile_ok = (Jw + 32 * kt) >= 0;
        const DA_LAS float* bp = tile_ok ? bias + (160 - 32 * kt) : negt + 32;
        f32x16 a;
#pragma unroll
        for (int i = 0; i < 16; ++i) a[i] = bp[-((i & 3) + 8 * (i >> 2))];
#pragma unroll
        for (int s = 0; s < 4; ++s) { const bf16x8 kf = *(const DA_LAS bf16x8*)(kp + s * 32); a = __builtin_amdgcn_mfma_f32_32x32x16_bf16(kf, qr[s], a, 0, 0, 0); }
        st[kt] = a; }
    float mx = -INFINITY;
#pragma unroll
    for (int kt = 0; kt < 5; ++kt)
#pragma unroll
        for (int i = 0; i < 16; ++i) mx = __builtin_fmaxf(mx, st[kt][i]);
    { auto rr = __builtin_amdgcn_permlane32_swap(__float_as_uint(mx), __float_as_uint(mx), false, false); mx = __builtin_fmaxf(__uint_as_float(rr[0]), __uint_as_float(rr[1])); }
    float den = 0.f;
#pragma unroll
    for (int kt = 0; kt < 5; ++kt)
#pragma unroll
        for (int i = 0; i < 16; ++i) { const float p = __builtin_amdgcn_exp2f(st[kt][i] - mx); st[kt][i] = p; den += p; }
    { auto rr = __builtin_amdgcn_permlane32_swap(__float_as_uint(den), __float_as_uint(den), false, false); den = __uint_as_float(rr[0]) + __uint_as_float(rr[1]); }
    f32x16 o[2]; o[0] = f32x16{}; o[1] = f32x16{};
    const DA_LAS char* vp0 = lds + LDS_V + (32 * wid + 4 * hi + ((lane >> 2) & 3)) * 64 + ((lane >> 4) & 1) * 32 + (lane & 3) * 8;
#pragma unroll
    for (int kt = 0; kt < 5; ++kt)
#pragma unroll
        for (int s2 = 0; s2 < 2; ++s2) { u32x4 pw; pw.x = cvtpk(st[kt][8 * s2 + 0], st[kt][8 * s2 + 1]); pw.y = cvtpk(st[kt][8 * s2 + 2], st[kt][8 * s2 + 3]); pw.z = cvtpk(st[kt][8 * s2 + 4], st[kt][8 * s2 + 5]); pw.w = cvtpk(st[kt][8 * s2 + 6], st[kt][8 * s2 + 7]);
            const bf16x8 pa = __builtin_bit_cast(bf16x8, pw);
#pragma unroll
            for (int dh = 0; dh < 2; ++dh) { const DA_LAS char* vp = vp0 + dh * V_HALF + (32 * kt + 16 * s2) * 64;
                const s16x4 lo = vtr(vp), hv = vtr(vp + 8 * 64);
                const bf16x8 vf = (bf16x8){lo[0], lo[1], lo[2], lo[3], hv[0], hv[1], hv[2], hv[3]};
                o[dh] = __builtin_amdgcn_mfma_f32_32x32x16_bf16(vf, pa, o[dh], 0, 0, 0); } }
    const float rl = __builtin_amdgcn_rcpf(den);
    if (hi == 0) lse2[qtok * NH + h] = mx + __builtin_amdgcn_logf(den);
    DA_LAS char* stg = lds + LDS_OST + wid * 4096;
#pragma unroll
    for (int dh = 0; dh < 2; ++dh)
#pragma unroll
        for (int ig = 0; ig < 4; ++ig) { const unsigned long long pk = (unsigned long long)cvtpk(o[dh][4 * ig] * rl, o[dh][4 * ig + 1] * rl) | ((unsigned long long)cvtpk(o[dh][4 * ig + 2] * rl, o[dh][4 * ig + 3] * rl) << 32);
            *(DA_LAS unsigned long long*)(stg + q32 * 128 + (((4 * dh + ig) ^ (q32 & 7)) * 16) + hi * 8) = pk; }
    asm volatile("s_waitcnt lgkmcnt(0)" ::: "memory");
#pragma unroll
    for (int i = 0; i < 4; ++i) { const int row = i * 8 + (lane >> 3), ch = lane & 7; const u32x4 v = *(const DA_LAS u32x4*)(stg + row * 128 + ((ch ^ (row & 7)) * 16));
        const size_t otok = rowbase + (size_t)(((I0 + 32 * wid + row) << dsh) + r);
#if ATT_WT
        asm volatile("global_store_dwordx4 %0, %1, off sc1\n\ts_nop 1" :: "v"(O + otok * DA + h * HD + ch * 8), "v"(v) : "memory"); }
#else
        *(u32x4*)(O + otok * DA + h * HD + ch * 8) = v; }
#endif
}
__device__ __forceinline__ void attn_phase(int u0, int u1, int u2, int count, int reps, const unsigned short* Q, const unsigned short* K, const unsigned short* V, unsigned short* O, float* lse2, const float* rel_bias, DA_LAS char* lds) {
    const int total = count * reps; if (total <= 0) return;
    int tid = threadIdx.x; asm volatile("" : "+v"(tid));
#define DA_UNIT(k_) ((k_) == 0 ? u0 : ((k_) == 1 ? u1 : u2))
    UnitRegs R; attn_load(u0, Q, K, V, R, tid);
    for (int i = tid; i < NH * TB + 64; i += 512) { const int hh_ = i / TB, dist = i - hh_ * TB - 32; const bool ok = (i < NH * TB) && dist >= 0 && dist <= 128; const int dcl = dist < 0 ? 0 : (dist > 128 ? 128 : dist);
        const float bvl = rel_bias[T5_BUCKET[hh_ < NH ? (hh_ >> 2) : 0][dcl] * NH + (hh_ < NH ? hh_ : 0)] * 1.4426950408889634f;
        ((DA_LAS float*)(lds + LDS_ALLB))[i] = ok ? bvl : -INFINITY; }
    for (int i = 0; i < total; ++i) { const int unit = DA_UNIT(i % count);
        asm volatile("" : "+v"(tid));
        attn_stage(unit, R, rel_bias, lds, tid);
#ifdef ATT_SREP
        for (int sr_ = 0; sr_ < ATT_SREP; ++sr_) { asm volatile("" ::: "memory"); attn_stage(unit, R, rel_bias, lds, tid); }
#endif
        bf16x8 qc[4];
#pragma unroll
        for (int s = 0; s < 4; ++s) qc[s] = R.qr[s];
        __syncthreads();
#ifdef ATT_LREP
        for (int lr_ = 0; lr_ < ATT_LREP; ++lr_) { if (i + 1 < total) attn_load(DA_UNIT((i + 1) % count), Q, K, V, R, tid);
#pragma unroll
            for (int z_ = 0; z_ < 6; ++z_) { asm volatile("" : "+v"(R.kv[z_]), "+v"(R.vv[z_])); }
#pragma unroll
            for (int z_ = 0; z_ < 4; ++z_) { asm volatile("" : "+v"(R.qr[z_])); } }
#endif
#ifndef ATT_LOAD_AFTER
        if (i + 1 < total) attn_load(DA_UNIT((i + 1) % count), Q, K, V, R, tid);
#endif
#ifdef ATT_CREP
        for (int cr_ = 0; cr_ < ATT_CREP; ++cr_) { attn_compute(unit, qc, O, lse2, lds, tid); asm volatile("" ::: "memory"); }
#endif
        attn_compute(unit, qc, O, lse2, lds, tid);
#ifdef ATT_LOAD_AFTER
        asm volatile("" ::: "memory"); __builtin_amdgcn_sched_barrier(0);
        if (i + 1 < total) attn_load(DA_UNIT((i + 1) % count), Q, K, V, R, tid);
#endif
        __syncthreads();
    }
}
constexpr int SR = ROWS_PER_TRIP;
__device__ __forceinline__ void scale_rows(unsigned short* O, const float* lse2, int m_lo, int m_hi, int step, int lane) {
    for (int m0 = m_lo; m0 < m_hi; m0 += SR * step) {
        unsigned long long w[SR][3]; float lv[SR][3][3];
#pragma unroll
        for (int rr = 0; rr < SR; ++rr) { const int m = (m0 + rr * step < m_hi) ? m0 + rr * step : m_lo; const float* l = lse2 + (size_t)m * NH;
#pragma unroll
            for (int k = 0; k < 3; ++k) { const int c = lane + 64 * k, hh = (c >> 4) & 3;
                w[rr][k] = *((const unsigned long long*)(O + (size_t)m * DA) + c); lv[rr][k][0] = l[hh]; lv[rr][k][1] = l[4 + hh]; lv[rr][k][2] = l[8 + hh]; } }
#pragma unroll
        for (int rr = 0; rr < SR; ++rr) { const int m = m0 + rr * step; if (m < m_hi) {
#pragma unroll
            for (int k = 0; k < 3; ++k) { const int c = lane + 64 * k, g = c >> 6;
                const float l0 = lv[rr][k][0], l1 = lv[rr][k][1], l2 = lv[rr][k][2]; const float mm = __builtin_fmaxf(__builtin_fmaxf(l0, l1), l2);
                const float e0 = __builtin_amdgcn_exp2f(l0 - mm), e1 = __builtin_amdgcn_exp2f(l1 - mm), e2 = __builtin_amdgcn_exp2f(l2 - mm);
                const float al = (g == 0 ? e0 : (g == 1 ? e1 : e2)) * __builtin_amdgcn_rcpf(e0 + e1 + e2);
                const unsigned w0 = (unsigned)w[rr][k], w1 = (unsigned)(w[rr][k] >> 32);
                const float f0 = __uint_as_float(w0 << 16) * al, f1 = __uint_as_float(w0 & 0xffff0000u) * al, f2 = __uint_as_float(w1 << 16) * al, f3 = __uint_as_float(w1 & 0xffff0000u) * al;
                const unsigned long long pk_ = (unsigned long long)cvtpk(f0, f1) | ((unsigned long long)cvtpk(f2, f3) << 32);
#if SCALE_WT
                asm volatile("global_store_dwordx2 %0, %1, off sc1\n\ts_nop 1" :: "v"((unsigned long long*)(O + (size_t)m * DA) + c), "v"(pk_) : "memory"); } } }
#else
                *((unsigned long long*)(O + (size_t)m * DA) + c) = pk_; } } }
#endif
    }
}
}
#define GAS __attribute__((address_space(1)))
#define LAS __attribute__((address_space(3)))
typedef unsigned short bf16;
typedef unsigned v4u __attribute__((ext_vector_type(4)));
typedef float f32x4 __attribute__((ext_vector_type(4)));
typedef short bf16x8 __attribute__((ext_vector_type(8)));
typedef GAS unsigned gu32;
typedef GAS unsigned long long gu64;
#define RLX_AGENT __ATOMIC_RELAXED, __HIP_MEMORY_SCOPE_AGENT
#define LDS_WAIT() asm volatile("s_waitcnt lgkmcnt(0)" ::: "memory")
#define VM_WAIT() asm volatile("s_waitcnt vmcnt(0)" ::: "memory")
__device__ __forceinline__ unsigned long long rt() { return __builtin_amdgcn_s_memrealtime(); }
__device__ __forceinline__ unsigned f2bf(float f) { unsigned u = __builtin_bit_cast(unsigned, f); return (u + 0x7fffu + ((u >> 16) & 1u)) >> 16; }
__device__ __forceinline__ unsigned pk2(float lo, float hi) { return f2bf(lo) | (f2bf(hi) << 16); }

#ifndef XB_EARLY_INV
#define XB_EARLY_INV 1
#endif
#ifndef XB_DIRECT_RELEASE
#define XB_DIRECT_RELEASE 1
#endif
#define XB_TMO      128
#define XB_XCNT(j)  (256  + 64 * (j))
#define XB_XSUB(j)  (1280 + 64 * (j))
#define XB_XGEN(j)  (2304 + 64 * (j))
#define XB_TOP      3328
#define XB_TOPGEN   3392
#define XCD_BAR_WORDS 3456
#define XB_SPIN_CAP (1u << 18)

__device__ __forceinline__ unsigned xb_ld(unsigned* p)              { return __hip_atomic_load(p, __ATOMIC_RELAXED, __HIP_MEMORY_SCOPE_AGENT); }
__device__ __forceinline__ unsigned xb_add(unsigned* p, unsigned v) { return __hip_atomic_fetch_add(p, v, __ATOMIC_RELAXED, __HIP_MEMORY_SCOPE_AGENT); }
__device__ __forceinline__ unsigned xb_xcc_id() { return (unsigned)__builtin_amdgcn_s_getreg((3 << 11) | 20) & 0xFu; }
#define XB_SPIN(cond, bar) do { unsigned _sp = 0; while (cond) { __builtin_amdgcn_s_sleep(1); \
    if ((++_sp & 255u) == 0u) { if (xb_ld(&(bar)[XB_TMO])) break; if (_sp > XB_SPIN_CAP) { atomicAdd(&(bar)[XB_TMO], 1u); break; } } } } while (0)

struct XcdBarrier {
    unsigned* bar; unsigned x;
    volatile LAS unsigned* st;
};

__device__ __forceinline__ XcdBarrier xcd_barrier_post(unsigned* bar, volatile LAS unsigned* st) {
    XcdBarrier b; b.bar = bar; b.x = xb_xcc_id(); b.st = st;
    if (threadIdx.x == 0) (void)xb_add(&bar[XB_XCNT(b.x)], 1u);
    return b;
}
__device__ __forceinline__ void xcd_barrier_complete(unsigned* bar, unsigned x, unsigned& nloc, unsigned& nx) {
    const unsigned G = gridDim.x * gridDim.y * gridDim.z;
    unsigned sum, cnt, mine, sp = 0u;
    for (;;) {
        sum = 0u; cnt = 0u; mine = 0u;
#pragma unroll
        for (unsigned j = 0; j < 16; ++j) { const unsigned c = xb_ld(&bar[XB_XCNT(j)]); sum += c; cnt += (c > 0u) ? 1u : 0u; mine = (j == x) ? c : mine; }
        if (sum == G) break;
        __builtin_amdgcn_s_sleep(1);
        if ((++sp & 255u) == 0u) { if (xb_ld(&bar[XB_TMO])) break; if (sp > XB_SPIN_CAP) { atomicAdd(&bar[XB_TMO], 1u); break; } }
    }
    nloc = mine > 0u ? mine : 1u; nx = cnt > 0u ? cnt : 1u;
}

__device__ __forceinline__ void xcd_barrier(const XcdBarrier& b) {
    asm volatile("s_waitcnt vmcnt(0)" ::: "memory");
    __syncthreads();
    if (threadIdx.x == 0) {
        unsigned* bar = b.bar;
        __builtin_amdgcn_s_waitcnt(0);
        unsigned nloc = b.st[0], nx = b.st[1];
        if (nloc == 0u) { xcd_barrier_complete(bar, b.x, nloc, nx); b.st[0] = nloc; b.st[1] = nx; }
        const unsigned old = xb_add(&bar[XB_XSUB(b.x)], 1u);
        const unsigned gen = old / nloc;
        if (old + 1u == (gen + 1u) * nloc) {
            __builtin_amdgcn_fence(__ATOMIC_RELEASE, "agent");
            asm volatile("s_waitcnt vmcnt(0)" ::: "memory");
            const unsigned og = xb_add(&bar[XB_TOP], 1u);
            const unsigned tg = og / nx;
#if XB_DIRECT_RELEASE
            if (og + 1u == (tg + 1u) * nx) {
#pragma unroll
                for (unsigned j = 0; j < 16; ++j) (void)xb_add(&bar[XB_XGEN(j)], 1u); }
#if XB_EARLY_INV
            __builtin_amdgcn_fence(__ATOMIC_ACQUIRE, "agent");
            XB_SPIN(xb_ld(&bar[XB_XGEN(b.x)]) == gen, bar);
            asm volatile("s_waitcnt vmcnt(0)" ::: "memory");
#else
            XB_SPIN(xb_ld(&bar[XB_XGEN(b.x)]) == gen, bar);
            __builtin_amdgcn_fence(__ATOMIC_ACQUIRE, "agent");
            asm volatile("s_waitcnt vmcnt(0)" ::: "memory");
#endif
#else
            if (og + 1u == (tg + 1u) * nx) xb_add(&bar[XB_TOPGEN], 1u);
            else XB_SPIN(xb_ld(&bar[XB_TOPGEN]) == tg, bar);
            __builtin_amdgcn_fence(__ATOMIC_ACQUIRE, "agent");
            xb_add(&bar[XB_XGEN(b.x)], 1u);
            asm volatile("s_waitcnt vmcnt(0)" ::: "memory");
#endif
        } else {
#if XB_EARLY_INV
            __builtin_amdgcn_fence(__ATOMIC_ACQUIRE, "agent");
            XB_SPIN(xb_ld(&bar[XB_XGEN(b.x)]) == gen, bar);
            asm volatile("s_waitcnt vmcnt(0)" ::: "memory");
#else
            XB_SPIN(xb_ld(&bar[XB_XGEN(b.x)]) == gen, bar);
            __builtin_amdgcn_fence(__ATOMIC_ACQUIRE, "agent");
            asm volatile("s_waitcnt vmcnt(0)" ::: "memory");
#endif
        }
    }
    __syncthreads();
}
#ifndef HALF_ROUNDS
#define HALF_ROUNDS false
#endif
constexpr int NWAVES = 8;
constexpr int BATCH = 2, SEQ = 8192, DM = 1024, M = BATCH * SEQ, DEPTH = 4, CONVW = 31, DATT = 768, NHEADS = 12, DFF = 2816;
constexpr size_t MiB = 1u << 20;
constexpr size_t WS_CTL = 0, CTL_ZERO_BYTES = 128 * 1024;
constexpr size_t WS_SSQ = 1 * MiB;
constexpr size_t WS_WPW1 = 4 * MiB, WS_WPW2 = 12 * MiB, WS_WQKV = 16 * MiB, WS_WO = 25 * MiB, WS_WGU = 28 * MiB, WS_WDN = 72 * MiB;
constexpr size_t WS_XB = 94 * MiB;
constexpr size_t WS_R = 126 * MiB;
constexpr size_t WS_LSE = 214 * MiB, WS_O = 215 * MiB, WS_END = 239 * MiB;
constexpr int CW_BAR = 4096, CW_SEAM = 16384;
constexpr int RING_BYTES = 131072, LDS_BYTES = HALF_ROUNDS ? 163840 : 147456, MISC_OFF = LDS_BYTES - 256, STATS_OFF = 131072;
static_assert(!HALF_ROUNDS || pg8::HALF_RING_BYTES <= MISC_OFF, "half-unit ring");
static_assert(dattn::LDS_END <= MISC_OFF, "attention LDS map");

template <int CTRL> __device__ __forceinline__ float dpp_quad(float v) { return __builtin_bit_cast(float, __builtin_amdgcn_update_dpp(0, __builtin_bit_cast(int, v), CTRL, 0xF, 0xF, true)); }
__device__ __forceinline__ float wave_sum(float v) {
#pragma unroll
    for (int o = 1; o < 64; o <<= 1) v += __shfl_xor(v, o);
    return v;
}
__device__ __forceinline__ void transpose_item(const float* W, int ldw, int c0, int k0, const float* gain, bf16* WT, int K, int r0, LAS float* scr, int lane) {
    const int kr = lane >> 4, cq = (lane & 15) * 4;
    const float* src = W + (size_t)(k0 + kr) * ldw + c0 + cq;
    f32x4 v[16];
#pragma unroll
    for (int i = 0; i < 16; ++i) v[i] = __builtin_nontemporal_load((const f32x4*)(src + (size_t)(4 * i) * ldw));
    if (gain) {
#pragma unroll
        for (int i = 0; i < 16; ++i) v[i] = v[i] * gain[k0 + 4 * i + kr]; }
#pragma unroll
    for (int i = 0; i < 16; ++i) { LAS float* d = scr + (4 * i + kr) * 65 + cq; d[0] = v[i].x; d[1] = v[i].y; d[2] = v[i].z; d[3] = v[i].w; }
    LDS_WAIT(); asm volatile("" ::: "memory");
    const int c = lane & 7;
#pragma unroll
    for (int j = 0; j < 8; ++j) { const int n = (lane >> 3) + 8 * j; const LAS float* s = scr + (8 * c) * 65 + n;
        v4u o; o.x = pg8::cvt_pk_bf16(s[0 * 65], s[1 * 65]); o.y = pg8::cvt_pk_bf16(s[2 * 65], s[3 * 65]); o.z = pg8::cvt_pk_bf16(s[4 * 65], s[5 * 65]); o.w = pg8::cvt_pk_bf16(s[6 * 65], s[7 * 65]);
        const int rr = r0 + n;
        bf16* dst = TILED_B ? WT + ((size_t)(rr >> 7) * (K >> 6) + (k0 >> 6)) * 8192 + (rr & 127) * 64 + 8 * c : WT + (size_t)rr * K + k0 + 8 * c;
        *(GAS v4u*)dst = o; }
    LDS_WAIT(); asm volatile("" ::: "memory");
}

#ifndef REP_PROL
#define REP_PROL 1
#endif
#ifndef ATT_STAGGER_TICKS
#define ATT_STAGGER_TICKS 0
#endif
#ifndef CONVERT_SCHED2
#define CONVERT_SCHED2 1
#endif
#ifndef CONVERT_IN_QKV
#define CONVERT_IN_QKV 1
#endif
#ifndef CONVERT_SPLIT
#define CONVERT_SPLIT 0
#endif
#ifndef REP_CONVERT
#define REP_CONVERT 1
#endif
#ifndef QHALF
#define QHALF 1
#endif
#ifndef GHALF
#define GHALF 0
#endif
#ifndef PROBE_LDA
#define PROBE_LDA 0
#endif
#ifndef PROBE_K
#define PROBE_K 0
#endif
#ifndef PROBE_EPI_MODE
#define PROBE_EPI_MODE 0
#endif
#ifndef REP_PW1
#define REP_PW1 1
#endif
#ifndef REP_CONV
#define REP_CONV 1
#endif
#ifndef REP_QKV
#define REP_QKV 1
#endif
#ifndef REP_ATT
#define REP_ATT 1
#endif
#ifndef REP_BAR
#define REP_BAR 1
#endif
#ifndef PROBE_RESID
#define PROBE_RESID 0
#endif
#ifndef SPREAD_CONVERT
#define SPREAD_CONVERT 1
#endif
#ifndef GU_ALIGN
#define GU_ALIGN true
#endif
#ifndef GU_SP2
#define GU_SP2 true
#endif
#ifndef REP_PROL_W
#define REP_PROL_W 1
#endif
#ifndef REP_PROL_X
#define REP_PROL_X 1
#endif
#ifndef FUSE_FINAL
#define FUSE_FINAL 0
#endif
#ifndef TILED_H
#define TILED_H false
#endif
#ifndef RESID_ALIGN
#define RESID_ALIGN true
#endif
#ifndef ATT_LOCAL
#define ATT_LOCAL 0
#endif
#ifndef LAST_STAGGER_TICKS
#define LAST_STAGGER_TICKS 0
#endif
#ifndef CONVERT_FIRST
#define CONVERT_FIRST 1
#endif
#ifndef REP_GU
#define REP_GU 1
#endif
struct Args { const float* in[18]; float* out; unsigned char* ws; int ph_lo, ph_hi; };

__device__ __forceinline__ void convert_layer_weights(const Args& a, int layer, LAS unsigned char* lds, int w, int nw, int wave, int lane, int part = 0) {
    LAS float* scr = (LAS float*)(lds + wave * 16640);
    unsigned char* ws = a.ws; const int j = layer >> 1;
    const float* norm_mix = a.in[1] + layer * DM; const float* norm_ffn = a.in[2] + layer * DM;
    constexpr int I_PW1 = 16 * 32, I_PW2 = 16 * 16, I_QKV = 16 * 36, I_WO = 12 * 16, I_GU = 16 * 88, I_DN = 44 * 16, I_MIX = I_PW1 + I_PW2;
    static_assert(I_QKV + I_WO == I_MIX, "items per mixer");
    const int it_lo = (part == 2) ? I_MIX : 0, it_hi = (part == 1) ? I_MIX : I_MIX + I_GU + I_DN;
    for (int it = it_lo + w; it < it_hi; it += nw) {
        int r = it;
        if (r < I_MIX) {
            if ((layer & 1) == 0) {
                if (r < I_PW1) { const int kb = r >> 5, nb = r & 31, n0 = nb * 64; const int src = ((n0 >> 7) & 1) * 1024 + (n0 >> 8) * 128 + (n0 & 127);
                    transpose_item(a.in[4] + (size_t)j * 1024 * 2048, 2048, src, kb * 64, norm_mix, (bf16*)(ws + WS_WPW1) + (size_t)j * 2048 * 1024, 1024, n0, scr, lane); }
                else { r -= I_PW1; const int kb = r >> 4, nb = r & 15;
                    transpose_item(a.in[10] + (size_t)j * 1024 * 1024, 1024, nb * 64, kb * 64, nullptr, (bf16*)(ws + WS_WPW2) + (size_t)j * 1024 * 1024, 1024, nb * 64, scr, lane); }
            } else {
                if (r < I_QKV) { const int kb = r / 36, nb = r % 36;
                    transpose_item(a.in[12] + (size_t)j * 1024 * 2304, 2304, nb * 64, kb * 64, norm_mix, (bf16*)(ws + WS_WQKV) + (size_t)j * 2304 * 1024, 1024, nb * 64, scr, lane); }
                else { r -= I_QKV; const int kb = r >> 4, nb = r & 15;
                    transpose_item(a.in[13] + (size_t)j * 768 * 1024, 1024, nb * 64, kb * 64, nullptr, (bf16*)(ws + WS_WO) + (size_t)j * 1024 * 768, 768, nb * 64, scr, lane); }
            }
            continue; }
        r -= I_MIX;
        if (r < I_GU) { const int kb = r / 88, nb = r % 88, n0 = nb * 64;
            const float* W = ((n0 >> 7) & 1) ? a.in[16] : a.in[15]; const int src = (n0 >> 8) * 128 + (n0 & 127);
            transpose_item(W + (size_t)layer * 1024 * DFF, DFF, src, kb * 64, norm_ffn, (bf16*)(ws + WS_WGU) + (size_t)layer * 5632 * 1024, 1024, n0, scr, lane); continue; }
        r -= I_GU;
        { const int kb = r >> 4, nb = r & 15;
            transpose_item(a.in[17] + (size_t)layer * DFF * 1024, 1024, nb * 64, kb * 64, nullptr, (bf16*)(ws + WS_WDN) + (size_t)layer * 1024 * DFF, DFF, nb * 64, scr, lane); }
    }
}
__device__ __forceinline__ void prologue(const Args& a, LAS unsigned char* lds, int gw, int ngw, int wave, int lane) {
    unsigned char* ws = a.ws;
    for (int rw = 0; rw < REP_PROL_W; ++rw) convert_layer_weights(a, 0, lds, gw, ngw, wave, lane);
#if !SPREAD_CONVERT
    for (int l = 1; l < DEPTH; ++l) convert_layer_weights(a, l, lds, gw, ngw, wave, lane);
#endif
    const float* x = a.in[0]; bf16* XB = (bf16*)(ws + WS_XB); pg8::ssq_t* ssq0 = (pg8::ssq_t*)(ws + WS_SSQ);
    const int nwgs = ngw / NWAVES, vblk = gw / NWAVES, rpw = (M + nwgs - 1) / nwgs, row_lo = vblk * rpw, row_hi = (row_lo + rpw < M) ? row_lo + rpw : M;
    { v4u* z = (v4u*)(ssq0 + M);
      for (int i = gw * 64 + lane; i < 8 * M * 8 / 16; i += ngw * 64) z[i] = (v4u){0u, 0u, 0u, 0u}; }
    for (int rx = 0; rx < REP_PROL_X; ++rx)
    for (int m0 = row_lo + (gw % NWAVES) * 4; m0 < row_hi; m0 += NWAVES * 4) {
        f32x4 v[4][4];
#pragma unroll
        for (int rr = 0; rr < 4; ++rr) { const GAS f32x4* xr = (const GAS f32x4*)(x + (size_t)(m0 + rr) * DM) + lane;
#pragma unroll
            for (int j = 0; j < 4; ++j) v[rr][j] = __builtin_nontemporal_load(xr + 64 * j); }
        float s[4];
#pragma unroll
        for (int rr = 0; rr < 4; ++rr) { s[rr] = 0.f;
#pragma unroll
            for (int j = 0; j < 4; ++j) s[rr] += (v[rr][j].x * v[rr][j].x + v[rr][j].y * v[rr][j].y) + (v[rr][j].z * v[rr][j].z + v[rr][j].w * v[rr][j].w); }
#pragma unroll
        for (int o = 1; o < 64; o <<= 1) {
#pragma unroll
            for (int rr = 0; rr < 4; ++rr) s[rr] += __shfl_xor(s[rr], o); }
#pragma unroll
        for (int rr = 0; rr < 4; ++rr) { GAS unsigned long long* o8 = (GAS unsigned long long*)(XB + (size_t)(m0 + rr) * DM) + lane;
#pragma unroll
            for (int j = 0; j < 4; ++j) o8[64 * j] = (unsigned long long)pg8::cvt_pk_bf16(v[rr][j].x, v[rr][j].y) | ((unsigned long long)pg8::cvt_pk_bf16(v[rr][j].z, v[rr][j].w) << 32);
            if (lane == 0) ssq0[m0 + rr] = pg8::ssq_enc(s[rr]); }
    }
}

typedef float f32x2 __attribute__((ext_vector_type(2)));
#ifndef CONV_WT
#define CONV_WT 0
#endif
constexpr int CONV_TT = 64, CONV_ROWS = CONV_TT + 30, CONV_RING = 16;
#define CONV_LOAD(R) (*(const GAS unsigned*)(ubase + (size_t)(((R) < 30 && tb - 30 + (R) < 0) ? 30 - tb : (R)) * (DM * 2)))
#define CONV_ROW(R) { unsigned xw_ = xq[(R) % CONV_RING]; if ((R) < 30 && tb - 30 + (R) < 0) xw_ = 0u; \
    if ((R) + CONV_RING < CONV_ROWS) xq[(R) % CONV_RING] = CONV_LOAD((R) + CONV_RING);     \
    f32x2 xv_; xv_.x = __uint_as_float(xw_ << 16); xv_.y = __uint_as_float(xw_ & 0xffff0000u); \
    _Pragma("unroll") for (int t = ((R) > 30 ? (R) - 30 : 0); t <= ((R) < CONV_TT ? (R) : CONV_TT - 1); ++t) a[t] += w[(R) - t] * xv_; \
    __builtin_amdgcn_sched_barrier(0); }
#define CONV_ROW2(B) CONV_ROW((B)) CONV_ROW((B) + 1)
#define CONV_ROW8(B) CONV_ROW2((B)) CONV_ROW2((B) + 2) CONV_ROW2((B) + 4) CONV_ROW2((B) + 6)
#define CONV_ROW32(B) CONV_ROW8((B)) CONV_ROW8((B) + 8) CONV_ROW8((B) + 16) CONV_ROW8((B) + 24)
__device__ __forceinline__ void conv_phase(const bf16* U, const float* wdw, const float* bdw, const float* lng, const float* lnb, bf16* C, LAS unsigned char* lds, int vcu, int G, int tid_) {
    f32x2 w[CONVW];
    { const int c0 = 2 * tid_;
#pragma unroll
      for (int k = 0; k < CONVW; ++k) w[k] = *(const f32x2*)(wdw + k * DM + c0); }
    constexpr int NT = M / CONV_TT; const int tpw = (NT + G - 1) / G;
    for (int ti = 0; ti < tpw * REP_CONV; ++ti) { const int tile = vcu * tpw + (ti % tpw); if (tile >= NT) break;
        int tid = tid_; asm volatile("" : "+v"(tid));
        const int c0 = 2 * tid, lane = tid & 63, wave = __builtin_amdgcn_readfirstlane(tid >> 6);
        const int m0 = tile * CONV_TT, tb = m0 & (SEQ - 1);
        const char* ubase = (const char*)U + ((ptrdiff_t)(m0 - 30) * DM + c0) * 2;
        const f32x2 bd = *(const f32x2*)(bdw + c0);
        __builtin_amdgcn_sched_barrier(0);
        unsigned xq[CONV_RING];
#pragma unroll
        for (int r = 0; r < CONV_RING; ++r) xq[r] = CONV_LOAD(r);
        __builtin_amdgcn_sched_barrier(0);
        f32x2 a[CONV_TT];
#pragma unroll
        for (int t = 0; t < CONV_TT; ++t) a[t] = bd;
        __builtin_amdgcn_sched_barrier(0);
        CONV_ROW32(0) CONV_ROW32(32) CONV_ROW8(64) CONV_ROW8(72) CONV_ROW8(80) CONV_ROW2(88) CONV_ROW2(90) CONV_ROW2(92)
#pragma unroll
        for (int t = 0; t < CONV_TT; ++t) asm volatile("" : "+v"(a[t]));
        LAS float* P = (LAS float*)lds + (tid >> 2); LAS float* stats = (LAS float*)(lds + 65536);
#pragma unroll
        for (int t = 0; t < CONV_TT; ++t) { float s1 = a[t].x + a[t].y, s2 = a[t].x * a[t].x + a[t].y * a[t].y;
            s1 += dpp_quad<0xB1>(s1); s2 += dpp_quad<0xB1>(s2); s1 += dpp_quad<0x4E>(s1); s2 += dpp_quad<0x4E>(s2);
            if ((tid & 3) == 0) { P[(2 * t) * 128] = s1; P[(2 * t + 1) * 128] = s2; } }
        __syncthreads();
        { const LAS float* Pr = (const LAS float*)lds + wave * 16 * 128 + lane;
          float sv[16];
#pragma unroll
          for (int j = 0; j < 16; ++j) sv[j] = Pr[j * 128] + Pr[j * 128 + 64];
#pragma unroll
          for (int o = 1; o < 64; o <<= 1) {
#pragma unroll
              for (int j = 0; j < 16; ++j) sv[j] += __shfl_xor(sv[j], o); }
          if (lane == 0) {
#pragma unroll
              for (int j = 0; j < 16; j += 2) { const float mean = sv[j] * (1.0f / DM), var = sv[j + 1] * (1.0f / DM) - mean * mean;
                  stats[wave * 16 + j] = mean; stats[wave * 16 + j + 1] = __builtin_amdgcn_rsqf(var + 1e-6f); } } }
        __syncthreads();
        const f32x2 g2 = *(const f32x2*)(lng + c0), b2 = *(const f32x2*)(lnb + c0);
        unsigned* crow = (unsigned*)((char*)C + (size_t)((unsigned)m0 * (DM * 2) + (unsigned)c0 * 2));
#pragma unroll
        for (int t = 0; t < CONV_TT; ++t) { const f32x2 mr = *(const LAS f32x2*)(stats + 2 * t);
            const f32x2 y = (a[t] - mr.x) * (g2 * mr.y) + b2;
            f32x2 e = y * (-1.4426950408889634f); e.x = __builtin_amdgcn_exp2f(e.x); e.y = __builtin_amdgcn_exp2f(e.y); e = e + 1.0f;
            const unsigned cw_ = pg8::cvt_pk_bf16(y.x * __builtin_amdgcn_rcpf(e.x), y.y * __builtin_amdgcn_rcpf(e.y));
#if CONV_WT
            asm volatile("global_store_dword %0, %1, off sc1" :: "v"(crow + t * (DM / 2)), "v"(cw_) : "memory"); }
#else
            crow[t * (DM / 2)] = cw_; }
#endif
        __syncthreads();
    }
}
#undef CONV_ROW32
#undef CONV_ROW8
#undef CONV_ROW2
#undef CONV_ROW
#undef CONV_LOAD

__global__ void __launch_bounds__(NWAVES * 64, 2) trunk_fwd(Args args) {
    extern __shared__ __attribute__((aligned(16))) unsigned char lds[];
    LAS unsigned char* L = (LAS unsigned char*)lds;
    volatile LAS unsigned* MISC = (volatile LAS unsigned*)(L + MISC_OFF);
    const int tid0 = threadIdx.x, wave = __builtin_amdgcn_readfirstlane(tid0 >> 6);
    const int G = gridDim.x, bx = blockIdx.x, vcu = (G % 8 == 0) ? (bx % 8) * (G / 8) + bx / 8 : bx;
    unsigned char* ws = args.ws;
    gu32* ctl = (gu32*)(ws + WS_CTL);
    if (tid0 < 64) MISC[tid0] = 0u;
    __syncthreads();
    XcdBarrier bar = xcd_barrier_post((unsigned*)(ctl + CW_BAR), MISC + 8);
    const int lo = args.ph_lo, hi = args.ph_hi; int pid = 0;
#define PH_BEGIN if (pid >= lo && pid < hi) { int tid = tid0; asm volatile("" : "+v"(tid)); const int lane = tid & 63; (void)lane;
#define PH_END   if (pid + 1 < hi) { for (int rb = 0; rb < REP_BAR; ++rb) xcd_barrier(bar); } } ++pid;
    bf16* XB = (bf16*)(ws + WS_XB); pg8::ssq_t* SSQ = (pg8::ssq_t*)(ws + WS_SSQ);
    bf16* R0 = (bf16*)(ws + WS_R);
    const int gw = vcu * NWAVES + wave, ngw = G * NWAVES;

    PH_BEGIN for (int rep = 0; rep < REP_PROL; ++rep) prologue(args, L, gw, ngw, wave, lane); PH_END

    for (int layer = 0; layer < DEPTH; ++layer) {
        const int j = layer >> 1;
        if ((layer & 1) == 0) {
            bf16* U = R0; bf16* C = R0 + (size_t)M * DM;
            PH_BEGIN
                pg8::Gemm g{XB, (const bf16*)(ws + WS_WPW1) + (size_t)j * 2048 * 1024, M, 2048, 1024, false}; pg8::StaticOrder S; S.init(M, 2048, G, bx);
                pg8::EpiGate<0> E{U, DM, SSQ + (size_t)layer * M, args.in[5] + j * 2048, false};
                for (int rep = 0; rep < REP_PW1; ++rep) { pg8::EpiGate<0> E2 = E; E2.probe = (rep + 1 < REP_PW1) ? PROBE_EPI_MODE : 0; pg8::Gemm g2 = g; if (PROBE_K > 0 && rep + 1 < REP_PW1) g2.K = PROBE_K; if (PROBE_LDA > 0 && rep + 1 < REP_PW1) g2.lda = PROBE_LDA; pg8::gemm_phase<pg8::EpiGate<0>, pg8::StaticOrder, true, true>(L, g2, S, E2); }
            PH_END
            PH_BEGIN
                conv_phase(U, args.in[6] + (size_t)j * CONVW * DM, args.in[7] + j * DM, args.in[8] + j * DM, args.in[9] + j * DM, C, L, vcu, G, tid);
            PH_END
            PH_BEGIN
                pg8::Gemm g{C, (const bf16*)(ws + WS_WPW2) + (size_t)j * 1024 * 1024, M, 1024, 1024, false}; pg8::StaticOrder S; S.init(M, 1024, G, bx);
                if (PROBE_RESID & 1) { pg8::EpiResid<false, true> E{nullptr, XB, U, DM, args.in[11] + j * DM, SSQ + (size_t)12 * M};
                    pg8::gemm_phase<pg8::EpiResid<false, true>, pg8::StaticOrder, RESID_ALIGN, true>(L, g, S, E); }
                if (layer == 0) { pg8::EpiResid<true, true> E{args.in[0], XB, XB, DM, args.in[11] + j * DM, SSQ + (size_t)(4 + layer) * M};
                    pg8::gemm_phase<pg8::EpiResid<true, true>, pg8::StaticOrder, RESID_ALIGN, true>(L, g, S, E); }
                else { pg8::EpiResid<false, true> E{nullptr, XB, XB, DM, args.in[11] + j * DM, SSQ + (size_t)(4 + layer) * M};
                    pg8::gemm_phase<pg8::EpiResid<false, true>, pg8::StaticOrder, RESID_ALIGN, true>(L, g, S, E); }
            PH_END
        } else {
            bf16* Qb = R0; bf16* Kb = R0 + (size_t)M * DATT; bf16* Vb = R0 + 2 * (size_t)M * DATT; float* LSE = (float*)(ws + WS_LSE); bf16* Ob = (bf16*)(ws + WS_O);
            PH_BEGIN
                const bool qhalf = HALF_ROUNDS && QHALF;
                pg8::Gemm g{XB, (const bf16*)(ws + WS_WQKV) + (size_t)j * 2304 * 1024, M, 2304, 1024, false}; pg8::StaticOrder S; S.init(M, 2304, G, bx, qhalf);
                pg8::EpiQkv E{Qb, DATT, SSQ + (size_t)layer * M, DATT, (size_t)M * DATT, 0.125f * 1.4426950408889634f};
#if SPREAD_CONVERT && CONVERT_IN_QKV
                if ((CONVERT_SCHED2 || layer + 1 < DEPTH) && !qhalf) {
                    const int rem = S.nwg % G, nidle = G - rem;
                    if (rem != 0 && bx >= rem) {
#if CONVERT_SCHED2
                        convert_layer_weights(args, layer, L, (bx - rem) * NWAVES + wave, nidle * NWAVES, wave, lane, 2);
                        if (layer + 1 < DEPTH) convert_layer_weights(args, layer + 1, L, (bx - rem) * NWAVES + wave, nidle * NWAVES, wave, lane, 1);
#else
                        if (layer + 1 < DEPTH) convert_layer_weights(args, layer + 1, L, (bx - rem) * NWAVES + wave, nidle * NWAVES, wave, lane);
#endif
                        __syncthreads(); } }
#endif
                for (int rep = 0; rep < REP_QKV; ++rep) { pg8::gemm_phase<pg8::EpiQkv, pg8::StaticOrder, true, true>(L, g, S, E); if (qhalf) pg8::gemm_half_phase<pg8::EpiQkv>(L, g, S, E); }
#if SPREAD_CONVERT
                if (false) {
                    const int rem = S.nwg % G, nidle = G - rem;
                    if (bx >= rem) convert_layer_weights(args, layer + 1, L, (bx - rem) * NWAVES + wave, nidle * NWAVES, wave, lane); }
#endif
            PH_END
            PH_BEGIN
                if (ATT_LOCAL && G == 256) {
                    const int x = bx & 7, w = bx >> 3, b = x >> 2, xq = x & 3; int ul[3];
#pragma unroll
                    for (int i = 0; i < 3; ++i) { const int lid = 3 * w + i; int h, u32i;
                        if (lid < 32) { h = lid >> 3; u32i = 8 * xq + (lid & 7); }
                        else if (lid < 64) { const int l = lid - 32, rem = l & 7; h = 4 + (l >> 3); u32i = (rem >> 1) * 8 + 2 * xq + (rem & 1); }
                        else { const int l = lid - 64; h = 8 + (l >> 3); u32i = (8 * (xq & 1) + (l & 7)) * 2 + (xq >> 1); }
                        ul[i] = (b * 12 + h) * 32 + u32i; }
                    dattn::attn_phase(ul[0], ul[1], ul[2], 3, REP_ATT, Qb, Kb, Vb, Ob, LSE, args.in[14], (LAS char*)L);
                } else {
                if (ATT_STAGGER_TICKS > 0 && ((bx >> 3) & 1)) {
                    const unsigned long long t0 = __builtin_amdgcn_s_memrealtime(); while (__builtin_amdgcn_s_memrealtime() - t0 < (unsigned long long)ATT_STAGGER_TICKS) __builtin_amdgcn_s_sleep(4); }
                const int upw = (dattn::NUNITS + G - 1) / G, first = vcu * upw, cnt = (first + upw <= dattn::NUNITS) ? upw : (dattn::NUNITS - first);
                for (int i0 = 0; i0 < cnt; i0 += 3) dattn::attn_phase(first + i0, first + i0 + 1, first + i0 + 2, (cnt - i0 < 3) ? cnt - i0 : 3, REP_ATT, Qb, Kb, Vb, Ob, LSE, args.in[14], (LAS char*)L); }
            PH_END
            PH_BEGIN
                { const int rpw = (M + G - 1) / G, row_lo = vcu * rpw, row_hi = (row_lo + rpw < M) ? row_lo + rpw : M; dattn::scale_rows(Ob, LSE, row_lo + wave, row_hi, NWAVES, lane); }
            PH_END
            PH_BEGIN
                pg8::Gemm g{Ob, (const bf16*)(ws + WS_WO) + (size_t)j * 1024 * 768, M, 1024, 768, false}; pg8::StaticOrder S; S.init(M, 1024, G, bx);
                if (PROBE_RESID & 2) { pg8::EpiResid<false, false> E{nullptr, XB, Qb, DM, nullptr, SSQ + (size_t)12 * M};
                    pg8::gemm_phase<pg8::EpiResid<false, false>, pg8::StaticOrder, RESID_ALIGN, true>(L, g, S, E); }
                pg8::EpiResid<false, false> E{nullptr, XB, XB, DM, nullptr, SSQ + (size_t)(4 + layer) * M};
                pg8::gemm_phase<pg8::EpiResid<false, false>, pg8::StaticOrder, RESID_ALIGN, true>(L, g, S, E);
            PH_END
        }
        bf16* H = R0;
        PH_BEGIN
            const bool ghalf = HALF_ROUNDS && GHALF && (layer + 1 >= DEPTH);
            pg8::Gemm g{XB, (const bf16*)(ws + WS_WGU) + (size_t)layer * 5632 * 1024, M, 5632, 1024, false}; pg8::StaticOrder S; S.init(M, 5632, G, bx, ghalf);
            pg8::EpiGate<1> E{H, DFF, SSQ + (size_t)(4 + layer) * M, nullptr, TILED_H};
#if SPREAD_CONVERT && CONVERT_FIRST
#if CONVERT_SCHED2
            if (layer + 1 < DEPTH && !ghalf) { const int rem = S.nwg % G, nidle = G - rem;
                if (bx >= rem) { convert_layer_weights(args, layer + 1, L, (bx - rem) * NWAVES + wave, nidle * NWAVES, wave, lane, (layer & 1) ? 2 : 1); __syncthreads(); } }
#else
            if (layer + 1 < DEPTH && !ghalf && !(CONVERT_IN_QKV && (layer & 1))) { const int rem = S.nwg % G, nidle = G - rem;
                if (bx >= rem) { for (int rc_ = 0; rc_ < REP_CONVERT; ++rc_) {
                    if (CONVERT_SPLIT) convert_layer_weights(args, layer + 1, L, (bx - rem) * NWAVES + wave, 2 * nidle * NWAVES, wave, lane);
                    else convert_layer_weights(args, layer + 1, L, (bx - rem) * NWAVES + wave, nidle * NWAVES, wave, lane);
                    __syncthreads(); } } }
#endif
            if (LAST_STAGGER_TICKS > 0 && layer + 1 >= DEPTH && !ghalf) { const int rem = S.nwg % G;
                if (rem != 0 && bx >= rem) { const unsigned long long t0 = __builtin_amdgcn_s_memrealtime(); while (__builtin_amdgcn_s_memrealtime() - t0 < (unsigned long long)LAST_STAGGER_TICKS) __builtin_amdgcn_s_sleep(8); } }
#endif
            for (int rep = 0; rep < REP_GU; ++rep) { pg8::gemm_phase<pg8::EpiGate<1>, pg8::StaticOrder, GU_ALIGN, GU_SP2>(L, g, S, E); if (ghalf) pg8::gemm_half_phase<pg8::EpiGate<1>>(L, g, S, E); }
#if SPREAD_CONVERT && CONVERT_FIRST
            if (CONVERT_SPLIT && layer + 1 < DEPTH && !ghalf) { const int rem = S.nwg % G, nidle = G - rem;
                if (bx >= rem) convert_layer_weights(args, layer + 1, L, (bx - rem) * NWAVES + wave + nidle * NWAVES, 2 * nidle * NWAVES, wave, lane); }
#endif
#if SPREAD_CONVERT && !CONVERT_FIRST
            if (layer + 1 < DEPTH && !ghalf) {
                const int rem = S.nwg % G, nidle = G - rem;
                if (bx >= rem) convert_layer_weights(args, layer + 1, L, (bx - rem) * NWAVES + wave, nidle * NWAVES, wave, lane); }
#endif
        PH_END
        PH_BEGIN
            pg8::Gemm g{H, (const bf16*)(ws + WS_WDN) + (size_t)layer * 1024 * DFF, M, 1024, DFF, TILED_H}; pg8::StaticOrder S; S.init(M, 1024, G, bx);
            if (PROBE_RESID & 4) { pg8::EpiResid<false, false> E{nullptr, XB, (bf16*)(ws + WS_LSE), DM, nullptr, SSQ + (size_t)12 * M};
                pg8::gemm_phase<pg8::EpiResid<false, false>, pg8::StaticOrder, RESID_ALIGN, true>(L, g, S, E); }
            if (FUSE_FINAL && layer == DEPTH - 1 && G >= (M / 256) * 4) {
                pg8::EpiFinal E{XB, args.out, DM, args.in[3], SSQ + (size_t)8 * M, (unsigned*)(ctl + CW_SEAM), (LAS unsigned*)(L + MISC_OFF + 64), 32u};
                pg8::gemm_phase<pg8::EpiFinal, pg8::StaticOrder, true, true>(L, g, S, E); }
            else {
            pg8::EpiResid<false, false> E{nullptr, XB, XB, DM, nullptr, SSQ + (size_t)(layer == DEPTH - 1 ? 8 : layer + 1) * M};
            pg8::gemm_phase<pg8::EpiResid<false, false>, pg8::StaticOrder, RESID_ALIGN, true>(L, g, S, E); }
        PH_END
    }
    PH_BEGIN
        const float* fn = args.in[3]; const pg8::ssq_t* ssq = SSQ + (size_t)8 * M; float* out = args.out;
        const int rpw = (M + G - 1) / G, row_lo = vcu * rpw, row_hi = (row_lo + rpw < M) ? row_lo + rpw : M;
        for (int m0 = row_lo + wave; m0 < row_hi; m0 += ROWS_PER_TRIP * NWAVES) {
            unsigned long long wv[ROWS_PER_TRIP][4]; float rsv[ROWS_PER_TRIP];
#pragma unroll
            for (int rr = 0; rr < ROWS_PER_TRIP; ++rr) { const int m = (m0 + rr * NWAVES < row_hi) ? m0 + rr * NWAVES : row_lo; rsv[rr] = pg8::rstd_of(ssq + m);
                const GAS unsigned long long* xr = (const GAS unsigned long long*)(XB + (size_t)m * DM) + lane;
#pragma unroll
                for (int q = 0; q < 4; ++q) wv[rr][q] = __builtin_nontemporal_load(xr + 64 * q); }
#pragma unroll
            for (int rr = 0; rr < ROWS_PER_TRIP; ++rr) { const int m = m0 + rr * NWAVES; if (m < row_hi) { GAS f32x4* orow = (GAS f32x4*)(out + (size_t)m * DM) + lane;
#pragma unroll
                for (int q = 0; q < 4; ++q) { const unsigned w0 = (unsigned)wv[rr][q], w1 = (unsigned)(wv[rr][q] >> 32); const f32x4 gq = *((const f32x4*)fn + lane + 64 * q);
                    const f32x4 v = (f32x4){__uint_as_float(w0 << 16), __uint_as_float(w0 & 0xffff0000u), __uint_as_float(w1 << 16), __uint_as_float(w1 & 0xffff0000u)};
                    __builtin_nontemporal_store(v * rsv[rr] * gq, orow + 64 * q); } } } }
    PH_END
#undef PH_BEGIN
#undef PH_END
}

constexpr int N_PHASES = 1 + 2 * 5 + 2 * 6 + 1;
#ifndef MK_PER_PHASE
#define MK_PER_PHASE 0
#endif
extern "C" void kernel_launch(void* const* d_in, const int* in_sizes, int n_in, void* d_out, int out_size, void* d_ws, size_t ws_size, hipStream_t stream) {
    static int grid = 0;
    if (grid == 0) {
        if (n_in != 18 || in_sizes[0] != M * DM || out_size != M * DM || ws_size < WS_END) { fprintf(stderr, "kernel_launch: unexpected shapes (n_in %d, in0 %d, out %d, ws %zu); nothing launched\n", n_in, n_in > 0 ? in_sizes[0] : -1, out_size, ws_size); grid = -1; return; }
        int dev = 0, cus = 0, per_cu = 0;
        if (hipGetDevice(&dev) != hipSuccess || hipDeviceGetAttribute(&cus, hipDeviceAttributeMultiprocessorCount, dev) != hipSuccess) { grid = -1; return; }
        if (hipFuncSetAttribute((const void*)trunk_fwd, hipFuncAttributeMaxDynamicSharedMemorySize, LDS_BYTES) != hipSuccess) { fprintf(stderr, "kernel_launch: hipFuncSetAttribute failed\n"); grid = -1; return; }
        if (hipOccupancyMaxActiveBlocksPerMultiprocessor(&per_cu, (const void*)trunk_fwd, NWAVES * 64, LDS_BYTES) != hipSuccess || per_cu < 1) { fprintf(stderr, "kernel_launch: occupancy query says %d blocks per CU\n", per_cu); }
        (void)hipGetLastError();
        grid = cus;
    }
    if (grid < 0) return;
    (void)hipMemsetAsync((char*)d_ws + WS_CTL, 0, CTL_ZERO_BYTES, stream);
    Args a{};
    for (int i = 0; i < 18; ++i) a.in[i] = (const float*)d_in[i];
    a.out = (float*)d_out; a.ws = (unsigned char*)d_ws;
#if MK_PER_PHASE
    for (int p = 0; p < N_PHASES; ++p) { a.ph_lo = p; a.ph_hi = p + 1; hipLaunchKernelGGL(trunk_fwd, dim3(grid), dim3(NWAVES * 64), LDS_BYTES, stream, a); }
#else
    a.ph_lo = 0; a.ph_hi = N_PHASES - ((FUSE_FINAL && grid >= (M / 256) * 4) ? 1 : 0); hipLaunchKernelGGL(trunk_fwd, dim3(grid), dim3(NWAVES * 64), LDS_BYTES, stream, a);
#endif
}
```
